# Optimizing an MI355X kernel written in HIP

```python
import jax, jax.numpy as jnp
from jax import lax
import numpy as np

D_MODEL = 1024
BATCH = 2
SEQ = 8192
DEPTH = 1
DEC_BATCH = 32
DEC_SEQ = 8
PAST_LEN = 16384
PAGE_SIZE = 128

ATT_GROUPS = ((128, 1), (512, 4), (2048, 16))
N_GROUPS = 3
ATT_HEADS = 8
ATT_HEAD_DIM = 64
ATT_WIDTH = ATT_HEADS * ATT_HEAD_DIM
WIN_STEPS = 128
ATT_SCALE = ATT_HEAD_DIM ** -0.5
N_BUCKETS = 32
MAX_DISTANCE = 2048
N_BIAS_HEADS = N_GROUPS * ATT_HEADS
M_HEADS = 4
M_WIDTH = D_MODEL
M_V_DIM = M_WIDTH // M_HEADS
M_QK_DIM = M_V_DIM // 2
CONV_WIDTH = 4
M_CHUNK = 64
EPS = 1e-6
PROJ_SIZES = (N_GROUPS * ATT_WIDTH, N_GROUPS * ATT_WIDTH, N_GROUPS * ATT_WIDTH, ATT_WIDTH,
              M_WIDTH, M_WIDTH, M_WIDTH, M_HEADS, M_HEADS, D_MODEL, D_MODEL)
PROJ_WIDTH = sum(PROJ_SIZES)

kernel_name = "dilated_attn_mlstm_gated_hybrid_step"


def _t5_bucket(dist):
    n = np.asarray(dist).astype(np.int64)
    max_exact = N_BUCKETS // 2
    nf = np.maximum(n, 1).astype(np.float32)
    large = max_exact + (np.log(nf / max_exact) / np.log(np.float32(MAX_DISTANCE / max_exact))
                         * (N_BUCKETS - max_exact)).astype(np.int64)
    large = np.minimum(large, N_BUCKETS - 1)
    return np.where(n < max_exact, n, large).astype(np.int32)


def _rmsnorm(x, gain):
    x32 = x.astype(jnp.float32)
    return x32 * lax.rsqrt(jnp.mean(x32 * x32, -1, keepdims=True) + EPS) * gain


def _head_norm(h, weight):
    mu = jnp.mean(h, -1, keepdims=True)
    hc = h - mu
    hn = hc * lax.rsqrt(jnp.mean(hc * hc, -1, keepdims=True) + EPS)
    B, S = h.shape[:2]
    return hn.reshape(B, S, -1) * weight


def _dilated_prompt(q, k, v, tbl, d):
    f32 = jnp.float32
    B, S, H, E = q.shape
    U = S // d
    nb = -(-U // WIN_STEPS)
    Up = nb * WIN_STEPS

    def res(t):
        t = t.astype(f32).reshape(B, U, d, H, E)
        return jnp.pad(t, ((0, 0), (0, Up - U), (0, 0), (0, 0), (0, 0)))

    def band(t):
        tp = jnp.pad(res(t), ((0, 0), (WIN_STEPS, 0), (0, 0), (0, 0), (0, 0)))
        prev = tp[:, :Up].reshape(B, nb, WIN_STEPS, d, H, E)
        cur = tp[:, WIN_STEPS:].reshape(B, nb, WIN_STEPS, d, H, E)
        return jnp.concatenate([prev, cur], axis=2)

    qr = res(q).reshape(B, nb, WIN_STEPS, d, H, E)
    kb, vb = band(k), band(v)
    qi = np.arange(WIN_STEPS)[:, None]
    kj = np.arange(2 * WIN_STEPS)[None, :]
    dist = qi - kj + WIN_STEPS
    in_band = (dist >= 0) & (dist <= WIN_STEPS)
    bucket = _t5_bucket(np.clip(dist, 0, WIN_STEPS) * d)
    bias = jnp.transpose(tbl[bucket], (2, 0, 1)).astype(f32)
    key_u = np.arange(nb)[:, None] * WIN_STEPS - WIN_STEPS + kj
    mask = in_band[None] & (key_u >= 0)[:, None, :]
    logits = jnp.einsum('bnqrhe,bnkrhe->bnrhqk', qr, kb) * ATT_SCALE + bias
    logits = jnp.where(mask[None, :, None, None], logits, -jnp.inf)
    mx = jnp.max(logits, -1, keepdims=True)
    p = jnp.exp(logits - mx)
    s = jnp.sum(p, -1)
    o = jnp.einsum('bnrhqk,bnkrhe->bnqrhe', p, vb) / jnp.transpose(s, (0, 1, 4, 2, 3))[..., None]
    lse = jnp.transpose(mx[..., 0] + jnp.log(s), (0, 1, 4, 2, 3))
    o = o.reshape(B, Up, d, H, E)[:, :U].reshape(B, S, H, E)
    lse = lse.reshape(B, Up, d, H)[:, :U].reshape(B, S, H)
    return o, lse


def _dilated_sample(q, k, v, buf, tbl, d):
    f32 = jnp.float32
    DB, T, H, E = q.shape
    Lb = buf.shape[1]
    kc = jnp.concatenate([buf[:, :, 0].astype(f32), k.astype(f32)], axis=1)
    vc = jnp.concatenate([buf[:, :, 1].astype(f32), v.astype(f32)], axis=1)
    J = WIN_STEPS + 1
    idx = Lb + np.arange(T)[:, None] - d * np.arange(J)[None, :]
    valid = idx >= 0
    idx_c = np.maximum(idx, 0)
    kg = kc[:, idx_c]
    vg = vc[:, idx_c]
    bias = jnp.transpose(tbl[_t5_bucket(d * np.arange(J))], (1, 0)).astype(f32)
    logits = jnp.einsum('bthe,btjhe->bhtj', q.astype(f32), kg) * ATT_SCALE + bias[None, :, None, :]
    logits = jnp.where(valid[None, None], logits, -jnp.inf)
    mx = jnp.max(logits, -1, keepdims=True)
    p = jnp.exp(logits - mx)
    s = jnp.sum(p, -1)
    o = jnp.einsum('bhtj,btjhe->bthe', p, vg) / jnp.transpose(s, (0, 2, 1))[..., None]
    lse = jnp.transpose(mx[..., 0] + jnp.log(s), (0, 2, 1))
    new_buf = jnp.concatenate([buf.astype(f32), jnp.stack([k.astype(f32), v.astype(f32)], axis=2)], axis=1)[:, T:]
    return o, lse, new_buf


def _mlstm(q, k, v, i_pre, f_pre, C0, n0, m0, chunk):
    f32 = jnp.float32
    B, S, NH, DK = q.shape
    DV = v.shape[-1]
    nc = S // chunk
    q = q.astype(f32) * (DK ** -0.5)
    logf = jax.nn.log_sigmoid(f_pre.astype(f32))

    def blocks(t):
        return jnp.swapaxes(t.astype(f32).reshape((B, nc, chunk) + t.shape[2:]), 0, 1).swapaxes(2, 3)

    xs = (blocks(q), blocks(k), blocks(v), blocks(i_pre), blocks(logf))
    causal = np.tril(np.ones((chunk, chunk), dtype=bool))

    def step(carry, inp):
        C, n, m = carry
        qc, kc, vc, ic, lfc = inp
        b = jnp.cumsum(lfc, axis=-1)
        Dm = jnp.where(causal, b[..., :, None] - b[..., None, :] + ic[..., None, :], -jnp.inf)
        inter = b + m[..., None]
        m_t = jnp.maximum(jnp.max(Dm, -1), inter)
        w_intra = jnp.exp(Dm - m_t[..., None])
        w_inter = jnp.exp(inter - m_t)
        sc = jnp.einsum('bhtk,bhsk->bhts', qc, kc) * w_intra
        num = jnp.einsum('bhts,bhsv->bhtv', sc, vc) + w_inter[..., None] * jnp.einsum('bhvk,bhtk->bhtv', C, qc)
        den = jnp.sum(sc, -1) + w_inter * jnp.einsum('bhk,bhtk->bht', n, qc)
        h = num / jnp.maximum(jnp.abs(den), jnp.exp(-m_t))[..., None]
        bL = b[..., -1]
        g = bL[..., None] - b + ic
        m_new = jnp.maximum(bL + m, jnp.max(g, -1))
        wk = jnp.exp(g - m_new[..., None])
        wC = jnp.exp(bL + m - m_new)
        C = wC[..., None, None] * C + jnp.einsum('bhs,bhsv,bhsk->bhvk', wk, vc, kc)
        n = wC[..., None] * n + jnp.einsum('bhs,bhsk->bhk', wk, kc)
        return (C, n, m_new), h

    (C, n, m), hs = lax.scan(step, (C0.astype(f32), n0.astype(f32), m0.astype(f32)), xs)
    h = jnp.transpose(hs, (1, 0, 3, 2, 4)).reshape(B, S, NH, DV)
    return h, C, n, m


def _layer(x, c, lp, rel_table, conv_prev, C0, n0, m0, kv_bufs, chunk):
    (norm_gain, w_ada, b_ada, w_in, b_if, conv_w, conv_b, w_mq, w_mk,
     m_norm, m_skip, w_pa, w_pm, w_out) = lp
    f32 = jnp.float32
    B, S, _ = x.shape
    ada = jax.nn.silu(c.astype(f32)) @ w_ada + b_ada
    shift, scale, gate = jnp.split(ada, 3, axis=-1)
    h = _rmsnorm(x, norm_gain) * (1.0 + scale[:, None]) + shift[:, None]
    proj = h @ w_in
    offs = [int(o) for o in np.cumsum(PROJ_SIZES)[:-1]]
    q_a, k_a, v_a, z_a, x_m, z_m, o_m, i_pre, f_pre, g_a, g_m = jnp.split(proj, offs, axis=-1)
    grp = (B, S, N_GROUPS, ATT_HEADS, ATT_HEAD_DIM)
    q_a, k_a, v_a = q_a.reshape(grp), k_a.reshape(grp), v_a.reshape(grp)

    outs, lses, new_bufs = [], [], []
    for g, (win, dil) in enumerate(ATT_GROUPS):
        tbl = rel_table[:, g * ATT_HEADS:(g + 1) * ATT_HEADS]
        if kv_bufs is None:
            o, lse = _dilated_prompt(q_a[:, :, g], k_a[:, :, g], v_a[:, :, g], tbl, dil)
            keep = min(win, S)
            buf = jnp.stack([k_a[:, S - keep:, g], v_a[:, S - keep:, g]], axis=2)
        else:
            o, lse, buf = _dilated_sample(q_a[:, :, g], k_a[:, :, g], v_a[:, :, g], kv_bufs[g], tbl, dil)
        outs.append(o)
        lses.append(lse)
        new_bufs.append(buf)
    alpha = jax.nn.softmax(jnp.stack(lses, 0), axis=0)
    o_att = jnp.sum(alpha[..., None] * jnp.stack(outs, 0), axis=0).reshape(B, S, ATT_WIDTH)
    a_branch = (o_att * jax.nn.silu(z_a)) @ w_pa

    conv_in = jnp.concatenate([conv_prev.astype(f32), x_m], axis=1)
    conv = conv_b + sum(conv_w[j] * conv_in[:, j:j + S] for j in range(CONV_WIDTH))
    c_act = jax.nn.silu(conv)
    new_conv = conv_in[:, S:]
    ch = c_act.reshape(B, S, M_HEADS, M_V_DIM)
    mq = jnp.einsum('bshe,hed->bshd', ch, w_mq)
    mk = jnp.einsum('bshe,hed->bshd', ch, w_mk)
    mv = x_m.reshape(B, S, M_HEADS, M_V_DIM)
    hcell, C, n, m = _mlstm(mq, mk, mv, i_pre + b_if[:M_HEADS], f_pre + b_if[M_HEADS:], C0, n0, m0, chunk)
    m_out = (jax.nn.sigmoid(o_m) * _head_norm(hcell, m_norm) + m_skip * c_act) * jax.nn.silu(z_m)
    m_branch = m_out @ w_pm

    merged = jax.nn.sigmoid(g_a) * a_branch + jax.nn.sigmoid(g_m) * m_branch
    y = x + gate[:, None] * (merged @ w_out)
    return y, new_bufs, new_conv, C, n, m


def setup_inputs(seed: int = 0) -> dict:
    key = jax.random.key(seed)
    ks = jax.random.split(key, 32)
    f32 = jnp.float32

    def nrm(k, shape, s):
        return jax.random.normal(k, shape, f32) * s

    lb = [min(w, PAST_LEN) for w, _ in ATT_GROUPS]
    kv_shape = lambda L: (DEPTH, DEC_BATCH, L, 2, ATT_HEADS, ATT_HEAD_DIM)
    b_i = nrm(ks[26], (DEPTH, M_HEADS), 0.1)
    b_f = 3.0 + jnp.linspace(0.0, 3.0, M_HEADS, dtype=f32)[None] + nrm(ks[27], (DEPTH, M_HEADS), 0.1)
    return {
        "x_prompt": nrm(ks[0], (BATCH, SEQ, D_MODEL), 1.0),
        "x_sample": nrm(ks[1], (DEC_BATCH, DEC_SEQ, D_MODEL), 1.0),
        "cache_kv_w128": nrm(ks[2], kv_shape(lb[0]), 1.0),
        "cache_kv_w512": nrm(ks[3], kv_shape(lb[1]), 1.0),
        "cache_kv_w2048": nrm(ks[4], kv_shape(lb[2]), 1.0),
        "state_conv": nrm(ks[5], (DEPTH, DEC_BATCH, CONV_WIDTH - 1, M_WIDTH), 1.0),
        "state_C": nrm(ks[6], (DEPTH, DEC_BATCH, M_HEADS, M_V_DIM, M_QK_DIM), 1.0),
        "state_n": nrm(ks[7], (DEPTH, DEC_BATCH, M_HEADS, M_QK_DIM), 1.0),
        "state_m": nrm(ks[8], (DEPTH, DEC_BATCH, M_HEADS), 0.5),
        "c_prompt": nrm(ks[9], (BATCH, D_MODEL), 1.0),
        "c_sample": nrm(ks[10], (DEC_BATCH, D_MODEL), 1.0),
        "rel_table": nrm(ks[11], (N_BUCKETS, N_BIAS_HEADS), 0.5),
        "norm_gain": 1.0 + nrm(ks[12], (DEPTH, D_MODEL), 0.1),
        "w_ada": nrm(ks[13], (DEPTH, D_MODEL, 3 * D_MODEL), 0.3 * D_MODEL ** -0.5),
        "b_ada": nrm(ks[14], (DEPTH, 3 * D_MODEL), 0.02),
        "w_in": nrm(ks[15], (DEPTH, D_MODEL, PROJ_WIDTH), D_MODEL ** -0.5),
        "b_if": jnp.concatenate([b_i, b_f], axis=-1),
        "conv_w": nrm(ks[16], (DEPTH, CONV_WIDTH, M_WIDTH), CONV_WIDTH ** -0.5),
        "conv_b": nrm(ks[17], (DEPTH, M_WIDTH), 0.02),
        "w_mq": nrm(ks[18], (DEPTH, M_HEADS, M_V_DIM, M_QK_DIM), M_V_DIM ** -0.5),
        "w_mk": nrm(ks[19], (DEPTH, M_HEADS, M_V_DIM, M_QK_DIM), M_V_DIM ** -0.5),
        "m_norm": 1.0 + nrm(ks[20], (DEPTH, M_WIDTH), 0.1),
        "m_skip": 1.0 + nrm(ks[21], (DEPTH, M_WIDTH), 0.1),
        "w_pa": nrm(ks[22], (DEPTH, ATT_WIDTH, D_MODEL), ATT_WIDTH ** -0.5),
        "w_pm": nrm(ks[23], (DEPTH, M_WIDTH, D_MODEL), M_WIDTH ** -0.5),
        "w_out": nrm(ks[24], (DEPTH, D_MODEL, D_MODEL), D_MODEL ** -0.5),
        "final_gain": 1.0 + nrm(ks[25], (D_MODEL,), 0.1),
    }


def reference(x_prompt, x_sample, cache_kv_w128, cache_kv_w512, cache_kv_w2048, state_conv, state_C,
              state_n, state_m, c_prompt, c_sample, rel_table, norm_gain, w_ada, b_ada, w_in, b_if,
              conv_w, conv_b, w_mq, w_mk, m_norm, m_skip, w_pa, w_pm, w_out, final_gain):
    f32 = jnp.float32
    B, S = x_prompt.shape[:2]
    T = x_sample.shape[1]
    names = ('kv128', 'kv512', 'kv2048', 'conv', 'C', 'n', 'm')
    new_p = {nm: [] for nm in names}
    new_s = {nm: [] for nm in names}
    xp, xs = x_prompt, x_sample
    for l in range(DEPTH):
        lp = (norm_gain[l], w_ada[l], b_ada[l], w_in[l], b_if[l], conv_w[l], conv_b[l], w_mq[l], w_mk[l],
              m_norm[l], m_skip[l], w_pa[l], w_pm[l], w_out[l])
        xp, bufs, cv, C, n, m = _layer(
            xp, c_prompt, lp, rel_table,
            jnp.zeros((B, CONV_WIDTH - 1, M_WIDTH), f32),
            jnp.zeros((B, M_HEADS, M_V_DIM, M_QK_DIM), f32),
            jnp.zeros((B, M_HEADS, M_QK_DIM), f32),
            jnp.zeros((B, M_HEADS), f32),
            None, min(M_CHUNK, S))
        for nm, val in zip(names, (bufs[0], bufs[1], bufs[2], cv, C, n, m)):
            new_p[nm].append(val)
        xs, bufs, cv, C, n, m = _layer(
            xs, c_sample, lp, rel_table, state_conv[l], state_C[l], state_n[l], state_m[l],
            (cache_kv_w128[l], cache_kv_w512[l], cache_kv_w2048[l]), T)
        for nm, val in zip(names, (bufs[0], bufs[1], bufs[2], cv, C, n, m)):
            new_s[nm].append(val)
    sp = {nm: jnp.stack(v, 0) for nm, v in new_p.items()}
    ss = {nm: jnp.stack(v, 0) for nm, v in new_s.items()}
    y_prompt = _rmsnorm(xp, final_gain).astype(x_prompt.dtype)
    y_sample = _rmsnorm(xs, final_gain).astype(x_sample.dtype)
    return (y_prompt, y_sample, sp['kv128'], ss['kv128'], sp['kv512'], ss['kv512'], sp['kv2048'], ss['kv2048'],
            sp['conv'], ss['conv'], sp['C'], ss['C'], sp['n'], ss['n'], sp['m'], ss['m'])
```

```cpp
#include <hip/hip_runtime.h>
#include <cstdio>
#include <cstdint>
namespace pg8 {
#define PG8_LAS __attribute__((address_space(3)))
typedef unsigned short bf16_t;
typedef short bf16x8 __attribute__((ext_vector_type(8)));
typedef float f32x4 __attribute__((ext_vector_type(4)));
typedef unsigned u32x4 __attribute__((ext_vector_type(4)));
constexpr int BM = 256, BK = 64, HALF = 128, HTB = HALF * BK * 2  , STAGE_BYTES = 8 * HTB, NXCD = 8, WGM = 8;

__host__ __device__ __forceinline__ int lds_byte(int r, int c) { const int st = (r >> 4) * 2 + (c >> 5), rr = r & 15, cc = c & 31, ob = rr * 64 + cc * 2; return st * 1024 + (ob ^ (((ob >> 9) & 1) << 5)); }
__host__ __device__ __forceinline__ void stage_rc(int b, int& R, int& C) { const int st = b / 1024, sb = b % 1024, swz = sb ^ (((sb >> 9) & 1) << 5); R = (st >> 1) * 16 + swz / 64; C = (st & 1) * 32 + (swz % 64) / 2; }
__host__ __device__ __forceinline__ int perm32(int rho) { const int n = rho >> 4, i = rho & 15; return 8 * (i >> 2) + 4 * n + (i & 3); }

struct Unit { int pm, pn; };
struct Gemm { const bf16_t* A; const bf16_t* Bt; int M, N, K, lda, a_pn_off; };

struct StaticOrder {
    int nM, nN, nwg, G, c;
    __host__ __device__ void init(int M, int N, int G_, int c_) { nM = M / BM; nN = N / BM; nwg = nM * nN; G = G_; c = c_; }
    __host__ __device__ bool next(int i, Unit& u) const {
        const long L = (long)i * G + c; if (L >= nwg) return false;
        int wgid = (int)L; { const int q = nwg / NXCD, r = nwg % NXCD, xcd = wgid % NXCD, off = wgid / NXCD; wgid = (xcd < r ? xcd * (q + 1) : r * (q + 1) + (xcd - r) * q) + off; }
        const int nig = WGM * nN, gid = wgid / nig, fm = gid * WGM, gsz = (nM - fm) < WGM ? (nM - fm) : WGM;
        u.pm = fm + ((wgid % nig) % gsz); u.pn = (wgid % nig) / gsz; return true;
    }
    __device__ __forceinline__ void a_ready(const Unit&) const {}
    __device__ __forceinline__ void done(const Unit&) const {}
};

typedef float cvt_f32x2_t __attribute__((ext_vector_type(2))); typedef __bf16 cvt_bf16x2_t __attribute__((ext_vector_type(2)));
__device__ __forceinline__ unsigned cvt_pk_bf16(float lo, float hi) { cvt_f32x2_t v = {lo, hi}; cvt_bf16x2_t b = __builtin_convertvector(v, cvt_bf16x2_t); return __builtin_bit_cast(unsigned, b); }
template <class Epi, class Sched, bool ALIGN_EPI = false, bool SP2 = false>
__device__ __forceinline__ void gemm_phase(PG8_LAS unsigned char* lds, const Gemm g, const Sched& S, const Epi& E) {
    const int tid = threadIdx.x, wid = __builtin_amdgcn_readfirstlane(tid >> 6), lane = tid & 63, wr = wid >> 2, wc = wid & 3, fr = lane & 15, fq = lane >> 4;
    const int K = g.K, nt = K / BK;
    unsigned voffA[2], voffB[2];
#pragma unroll
    for (int i = 0; i < 2; ++i) { int R, C; stage_rc(tid * 16 + i * 8192, R, C); const int Rb = Epi::PERM ? ((R & ~31) + perm32(R & 31)) : R;
        voffA[i] = (unsigned)(R * g.lda + C) * 2u; voffB[i] = (unsigned)(Rb * K + C) * 2u; }
    const size_t kstep = (size_t)(BK * 2);
    const size_t hstepA = (size_t)HALF * g.lda * 2, hstepB = (size_t)HALF * K * 2;
    const size_t tstepA = 2 * hstepA, tstepB = 2 * hstepB;
    const size_t apn = (size_t)g.a_pn_off * 2;
    const unsigned ldsw = (unsigned)wid * 1024u;
    const int aoff = lds_byte(wr * 64 + fr, fq * 8), boff = lds_byte(wc * 32 + fr, fq * 8);
#define PG8_SA(b, h) (((b) * 2 + (h)) * HTB)
#define PG8_SB(b, h) ((4 + (b) * 2 + (h)) * HTB)
#define PG8_STAGE(bufoff, gbase, voff) do { _Pragma("unroll") for (int _i = 0; _i < 2; ++_i) \
        __builtin_amdgcn_global_load_lds((const unsigned*)((const char*)(gbase) + (voff)[_i]), (PG8_LAS unsigned*)(lds + (bufoff) + ldsw + _i * 8192), 16, 0, 0); } while (0)
#define PG8_LDA(dst, b, h) do { _Pragma("unroll") for (int m = 0; m < 4; ++m) _Pragma("unroll") for (int k = 0; k < 2; ++k) dst[m][k] = *(const PG8_LAS bf16x8*)(lds + PG8_SA(b, h) + aoff + m * 2048 + k * 1024); } while (0)
#define PG8_LDB(dst, b, h) do { _Pragma("unroll") for (int n = 0; n < 2; ++n) _Pragma("unroll") for (int k = 0; k < 2; ++k) dst[n][k] = *(const PG8_LAS bf16x8*)(lds + PG8_SB(b, h) + boff + n * 2048 + k * 1024); } while (0)
#define PG8_MMA(ai, bj, At, Bt) do { __builtin_amdgcn_s_setprio(1); _Pragma("unroll") for (int m = 0; m < 4; ++m) _Pragma("unroll") for (int n = 0; n < 2; ++n) _Pragma("unroll") for (int k = 0; k < 2; ++k) \
        acc[ai][bj][m][n] = __builtin_amdgcn_mfma_f32_16x16x32_bf16(Bt[n][k], At[m][k], acc[ai][bj][m][n], 0, 0, 0); __builtin_amdgcn_s_setprio(0); } while (0)
#define PG8_WAIT_V(n) asm volatile("s_waitcnt vmcnt(" #n ")" ::: "memory")
#define PG8_WAIT_L(n) asm volatile("s_waitcnt lgkmcnt(" #n ")" ::: "memory")
#define PG8_BAR __builtin_amdgcn_s_barrier()
#define PG8_SCHED __builtin_amdgcn_sched_barrier(0)
    Unit cur, nxt; int ui = 0;
    if (!S.next(0, cur)) return;
    f32x4 acc[2][2][4][2];
#pragma unroll
    for (int a = 0; a < 2; ++a)
#pragma unroll
        for (int b = 0; b < 2; ++b)
#pragma unroll
            for (int m = 0; m < 4; ++m)
#pragma unroll
                for (int n = 0; n < 2; ++n) acc[a][b][m][n] = (f32x4){0.f, 0.f, 0.f, 0.f};
    bf16x8 At[4][2], B0[2][2], B1[2][2];
    const char* cA = (const char*)g.A + (size_t)cur.pm * tstepA + (size_t)cur.pn * apn; const char* cB = (const char*)g.Bt + (size_t)cur.pn * tstepB;
    S.a_ready(cur);
    if constexpr (SP2) {
        PG8_STAGE(PG8_SB(0, 0), cB, voffB); PG8_STAGE(PG8_SB(0, 1), cB + hstepB, voffB); PG8_STAGE(PG8_SA(0, 0), cA, voffA); PG8_STAGE(PG8_SA(0, 1), cA + hstepA, voffA);
        if (wr == 1) PG8_BAR;
        PG8_WAIT_V(2); PG8_BAR;
        PG8_STAGE(PG8_SB(1, 0), cB + kstep, voffB); PG8_STAGE(PG8_SA(1, 0), cA + kstep, voffA); PG8_STAGE(PG8_SB(1, 1), cB + hstepB + kstep, voffB);
        PG8_WAIT_V(6); PG8_BAR;
    } else {
        PG8_STAGE(PG8_SB(0, 0), cB, voffB); PG8_STAGE(PG8_SA(0, 0), cA, voffA); PG8_STAGE(PG8_SB(0, 1), cB + hstepB, voffB); PG8_STAGE(PG8_SA(0, 1), cA + hstepA, voffA);
        if (wr == 1) PG8_BAR;
        PG8_WAIT_V(4); PG8_BAR;
        PG8_STAGE(PG8_SB(1, 0), cB + kstep, voffB); PG8_STAGE(PG8_SA(1, 0), cA + kstep, voffA); PG8_STAGE(PG8_SB(1, 1), cB + hstepB + kstep, voffB);
        PG8_WAIT_V(6); PG8_BAR;
    }
    for (;;) {
        const bool has_next = S.next(ui + 1, nxt);
        const char* nA = has_next ? (const char*)g.A + (size_t)nxt.pm * tstepA + (size_t)nxt.pn * apn : cA; const char* nB = has_next ? (const char*)g.Bt + (size_t)nxt.pn * tstepB : cB;
#pragma nounroll
        for (int t = 0; t < nt; t += 2) {
            const bool last = (t == nt - 2);
            const char* a1 = cA + (size_t)(t + 1) * kstep;
            const char* a2 = last ? nA : cA + (size_t)(t + 2) * kstep; const char* b2 = last ? nB : cB + (size_t)(t + 2) * kstep;
            const char* a3 = a2 + kstep; const char* b3 = b2 + kstep;
            if (last && has_next) S.a_ready(nxt);
            if constexpr (SP2) {
            PG8_LDB(B0, 0, 0); PG8_LDB(B1, 0, 1); PG8_SCHED; PG8_LDA(At, 0, 0); PG8_STAGE(PG8_SA(1, 1), a1 + hstepA, voffA);
            PG8_WAIT_V(8); PG8_WAIT_L(0); PG8_BAR; PG8_MMA(0, 0, At, B0); PG8_MMA(0, 1, At, B1); PG8_BAR; PG8_SCHED;
            PG8_LDA(At, 0, 1); PG8_STAGE(PG8_SB(0, 0), b2, voffB); PG8_STAGE(PG8_SB(0, 1), b2 + hstepB, voffB); PG8_STAGE(PG8_SA(0, 0), a2, voffA);
            PG8_WAIT_V(8); PG8_WAIT_L(0); PG8_BAR; PG8_MMA(1, 0, At, B0); PG8_MMA(1, 1, At, B1); PG8_BAR; PG8_SCHED;
            PG8_LDB(B0, 1, 0); PG8_LDB(B1, 1, 1); PG8_SCHED; PG8_LDA(At, 1, 0); PG8_STAGE(PG8_SA(0, 1), a2 + hstepA, voffA);
            PG8_WAIT_V(8); PG8_WAIT_L(0); PG8_BAR; PG8_MMA(0, 0, At, B0); PG8_MMA(0, 1, At, B1); PG8_BAR; PG8_SCHED;
            PG8_LDA(At, 1, 1); PG8_STAGE(PG8_SB(1, 0), b3, voffB); PG8_STAGE(PG8_SB(1, 1), b3 + hstepB, voffB); PG8_STAGE(PG8_SA(1, 0), a3, voffA);
            PG8_WAIT_V(8); PG8_WAIT_L(0); PG8_BAR; PG8_MMA(1, 0, At, B0); PG8_MMA(1, 1, At, B1); PG8_BAR; PG8_SCHED;
            } else {
            PG8_LDB(B0, 0, 0); PG8_SCHED; PG8_LDA(At, 0, 0); PG8_STAGE(PG8_SA(1, 1), a1 + hstepA, voffA);
            PG8_WAIT_L(8); PG8_BAR; PG8_WAIT_L(0); PG8_MMA(0, 0, At, B0); PG8_BAR; PG8_SCHED;
            PG8_LDB(B1, 0, 1); PG8_STAGE(PG8_SB(0, 0), b2, voffB);
            PG8_BAR; PG8_WAIT_L(0); PG8_MMA(0, 1, At, B1); PG8_BAR;
            PG8_LDA(At, 0, 1); PG8_STAGE(PG8_SA(0, 0), a2, voffA);
            PG8_BAR; PG8_WAIT_L(0); PG8_MMA(1, 0, At, B0); PG8_BAR; PG8_SCHED;
            PG8_STAGE(PG8_SB(0, 1), b2 + hstepB, voffB);
            PG8_WAIT_V(6); PG8_BAR; PG8_MMA(1, 1, At, B1); PG8_BAR;
            PG8_LDB(B0, 1, 0); PG8_SCHED; PG8_LDA(At, 1, 0); PG8_STAGE(PG8_SA(0, 1), a2 + hstepA, voffA);
            PG8_WAIT_L(8); PG8_BAR; PG8_WAIT_L(0); PG8_MMA(0, 0, At, B0); PG8_BAR; PG8_SCHED;
            PG8_LDB(B1, 1, 1); PG8_STAGE(PG8_SB(1, 0), b3, voffB);
            PG8_BAR; PG8_WAIT_L(0); PG8_MMA(0, 1, At, B1); PG8_BAR;
            PG8_LDA(At, 1, 1); PG8_STAGE(PG8_SA(1, 0), a3, voffA);
            PG8_BAR; PG8_WAIT_L(0); PG8_MMA(1, 0, At, B0); PG8_BAR; PG8_SCHED;
            PG8_STAGE(PG8_SB(1, 1), b3 + hstepB, voffB);
            PG8_WAIT_V(6); PG8_BAR; PG8_MMA(1, 1, At, B1); PG8_BAR;
            }
        }
        if constexpr (ALIGN_EPI) { if (wr == 0) PG8_BAR; }
        if constexpr (!Epi::AFTER_DRAIN) { E(acc, cur, wr, wc, fr, fq); S.done(cur); }
        if (!has_next) break;
#pragma unroll
        for (int a = 0; a < 2; ++a)
#pragma unroll
            for (int b = 0; b < 2; ++b)
#pragma unroll
                for (int m = 0; m < 4; ++m)
#pragma unroll
                    for (int n = 0; n < 2; ++n) acc[a][b][m][n] = (f32x4){0.f, 0.f, 0.f, 0.f};
        cur = nxt; cA = nA; cB = nB; ++ui;
        if constexpr (ALIGN_EPI) { if (wr == 1) PG8_BAR; }
    }
    PG8_WAIT_V(0);
    if constexpr (!ALIGN_EPI) { if (wr == 0) PG8_BAR; }
    PG8_BAR;
    if constexpr (Epi::AFTER_DRAIN) { E.fused(acc, cur, wr, wc, fr, fq, lds, wid, lane); S.done(cur); }
#undef PG8_SA
#undef PG8_SB
#undef PG8_STAGE
#undef PG8_LDA
#undef PG8_LDB
#undef PG8_MMA
#undef PG8_WAIT_V
#undef PG8_WAIT_L
#undef PG8_BAR
#undef PG8_SCHED
}
}

constexpr int DMODEL = 1024;
constexpr int NBP = 2, SEQ = 8192, MP = NBP * SEQ;
constexpr int DBS = 32, TS = 8, MS = DBS * TS;
constexpr int M = MP + MS;
constexpr int PROJ_W = 10248, NREG = 10240;
constexpr int NBATCH = NBP + DBS;
constexpr float EPS = 1e-6f;
enum { I_XP = 0, I_XS, I_KV128, I_KV512, I_KV2048, I_SCONV, I_SC, I_SN, I_SM, I_CP, I_CS, I_REL, I_NG, I_WADA, I_BADA, I_WIN, I_BIF,
       I_CONVW, I_CONVB, I_WMQ, I_WMK, I_MNORM, I_MSKIP, I_WPA, I_WPM, I_WOUT, I_FG, N_IN };
constexpr size_t O_YP = 0;
constexpr size_t O_YS = O_YP + (size_t)MP * 1024;
constexpr size_t O_KV128P = O_YS + (size_t)MS * 1024;
constexpr size_t O_KV128S = O_KV128P + (size_t)NBP * 128 * 1024;
constexpr size_t O_KV512P = O_KV128S + (size_t)DBS * 128 * 1024;
constexpr size_t O_KV512S = O_KV512P + (size_t)NBP * 512 * 1024;
constexpr size_t O_KV2048P = O_KV512S + (size_t)DBS * 512 * 1024;
constexpr size_t O_KV2048S = O_KV2048P + (size_t)NBP * 2048 * 1024;
constexpr size_t O_CONVP = O_KV2048S + (size_t)DBS * 2048 * 1024;
constexpr size_t O_CONVS = O_CONVP + (size_t)NBP * 3 * 1024;
constexpr size_t O_CSTP = O_CONVS + (size_t)DBS * 3 * 1024;
constexpr size_t O_CSTS = O_CSTP + (size_t)NBP * 4 * 256 * 128;
constexpr size_t O_NP = O_CSTS + (size_t)DBS * 4 * 256 * 128;
constexpr size_t O_NS = O_NP + (size_t)NBP * 4 * 128;
constexpr size_t O_MP = O_NS + (size_t)DBS * 4 * 128;
constexpr size_t O_MS = O_MP + (size_t)NBP * 4;
constexpr size_t O_END = O_MS + (size_t)DBS * 4;

constexpr size_t wsal(size_t x) { return (x + 65535) & ~(size_t)65535; }
constexpr size_t WS_CTL = 0, CTL_ZERO_BYTES = 1u << 20;
constexpr size_t WS_WIN = wsal(WS_CTL + CTL_ZERO_BYTES);
constexpr size_t WS_WQK = wsal(WS_WIN + (size_t)NREG * 1024 * 2);
constexpr size_t WS_WPA = wsal(WS_WQK + (size_t)1024 * 256 * 2);
constexpr size_t WS_WPM = wsal(WS_WPA + (size_t)1024 * 512 * 2);
constexpr size_t WS_WOUT = wsal(WS_WPM + (size_t)1024 * 1024 * 2);
constexpr size_t WS_ADAP = wsal(WS_WOUT + (size_t)1024 * 1024 * 2);
constexpr size_t WS_GATE = wsal(WS_ADAP + (size_t)4 * NBATCH * 3072 * 4);
constexpr size_t WS_GATES = wsal(WS_GATE + (size_t)NBATCH * 1024 * 4);
constexpr size_t WS_HN = wsal(WS_GATES + (size_t)M * 8 * 4);
constexpr size_t WS_QKV = wsal(WS_HN + (size_t)M * 1024 * 2);
constexpr size_t WS_ZA = wsal(WS_QKV + (size_t)M * 4608 * 2);
constexpr size_t WS_XM = wsal(WS_ZA + (size_t)M * 512 * 2);
constexpr size_t WS_ZM = wsal(WS_XM + (size_t)M * 1024 * 2);
constexpr size_t WS_OM = wsal(WS_ZM + (size_t)M * 1024 * 2);
constexpr size_t WS_GA = wsal(WS_OM + (size_t)M * 1024 * 2);
constexpr size_t WS_GM = wsal(WS_GA + (size_t)M * 1024 * 2);
constexpr size_t WS_CACT = wsal(WS_GM + (size_t)M * 1024 * 2);
constexpr size_t WS_QM = wsal(WS_CACT + (size_t)M * 1024 * 2);
constexpr size_t WS_KM = wsal(WS_QM + (size_t)M * 512 * 2);
constexpr size_t WS_OG = wsal(WS_KM + (size_t)M * 512 * 2);
constexpr size_t WS_LSE = wsal(WS_OG + (size_t)M * 1536 * 2);
constexpr size_t WS_A3 = wsal(WS_LSE + (size_t)M * 24 * 4);
constexpr size_t WS_A4 = wsal(WS_A3 + (size_t)M * 512 * 2);
constexpr size_t WS_PA = wsal(WS_A4 + (size_t)M * 1024 * 2);
constexpr size_t WS_MRG = wsal(WS_PA + (size_t)M * 1024 * 2);
constexpr int NCH = 64, LCH = 128, NUNIT = NBP * 4 * NCH;
constexpr size_t WS_DCP = wsal(WS_MRG + (size_t)M * 1024 * 2);
constexpr size_t WS_DNP = wsal(WS_DCP + (size_t)NUNIT * 32768 * 2);
constexpr size_t WS_CHST = wsal(WS_DNP + (size_t)NUNIT * 128 * 4);
constexpr size_t WS_CPREV = wsal(WS_CHST + (size_t)NUNIT * 2 * 4);
constexpr size_t WS_NPREV = wsal(WS_CPREV + (size_t)NUNIT * 32768 * 2);
constexpr size_t WS_MPREV = wsal(WS_NPREV + (size_t)NUNIT * 128 * 4);
constexpr size_t WS_SSQ = wsal(WS_MPREV + (size_t)NUNIT * 4);
constexpr size_t WS_END = wsal(WS_SSQ + (size_t)M * 16 * 4);
constexpr int CW_BAR = 4096;

constexpr int RING_BYTES = 131072, LDSCTL_OFF = RING_BYTES, MISC_OFF = LDSCTL_OFF + 320, LDS_BYTES = 147456;
constexpr int NWAVES = 8, NTHREADS = 512;

#define GAS __attribute__((address_space(1)))
#define LAS __attribute__((address_space(3)))
typedef unsigned short bf16;
typedef unsigned v4u __attribute__((ext_vector_type(4)));
typedef unsigned v2u __attribute__((ext_vector_type(2)));
typedef float f32x4 __attribute__((ext_vector_type(4)));
typedef float f32x16 __attribute__((ext_vector_type(16)));
typedef short bf16x8 __attribute__((ext_vector_type(8)));
typedef short s16x4 __attribute__((ext_vector_type(4)));
typedef GAS unsigned gu32;
#define RLX_AGENT __ATOMIC_RELAXED, __HIP_MEMORY_SCOPE_AGENT
#define LDS_WAIT() asm volatile("s_waitcnt lgkmcnt(0)" ::: "memory")
#define VM_WAIT() asm volatile("s_waitcnt vmcnt(0)" ::: "memory")
__device__ __forceinline__ unsigned f2bf(float f) { unsigned u = __builtin_bit_cast(unsigned, f); return (u + 0x7fffu + ((u >> 16) & 1u)) >> 16; }
__device__ __forceinline__ unsigned pk2(float lo, float hi) { return f2bf(lo) | (f2bf(hi) << 16); }
__device__ __forceinline__ float bflo(unsigned w) { return __builtin_bit_cast(float, w << 16); }
__device__ __forceinline__ float bfhi(unsigned w) { return __builtin_bit_cast(float, w & 0xffff0000u); }
__device__ __forceinline__ float bf1(bf16 h) { return __builtin_bit_cast(float, (unsigned)h << 16); }
__device__ __forceinline__ float fast_rcp(float x) { return __builtin_amdgcn_rcpf(x); }
__device__ __forceinline__ float sigmoidf_(float x) { return fast_rcp(1.f + __expf(-x)); }
__device__ __forceinline__ float siluf_(float x) { return x * sigmoidf_(x); }
__device__ __forceinline__ float logsigmoidf_(float x) { return fminf(x, 0.f) - log1pf(__expf(-fabsf(x))); }
__device__ __forceinline__ float wave_sum(float v) {
#pragma unroll
    for (int o = 1; o < 64; o <<= 1) v += __shfl_xor(v, o);
    return v;
}
__device__ __forceinline__ float wave_max(float v) {
#pragma unroll
    for (int o = 1; o < 64; o <<= 1) v = fmaxf(v, __shfl_xor(v, o));
    return v;
}
#define XB_TMO      128
#define XB_XCNT(j)  (256  + 64 * (j))
#define XB_XSUB(j)  (1280 + 64 * (j))
#define XB_XGEN(j)  (2304 + 64 * (j))
#define XB_TOP      3328
#define XB_TOPGEN   3392
#define XCD_BAR_WORDS 3456
#define XB_SPIN_CAP (1u << 18)

__device__ __forceinline__ unsigned xb_ld(unsigned* p)              { return __hip_atomic_load(p, __ATOMIC_RELAXED, __HIP_MEMORY_SCOPE_AGENT); }
__device__ __forceinline__ unsigned xb_add(unsigned* p, unsigned v) { return __hip_atomic_fetch_add(p, v, __ATOMIC_RELAXED, __HIP_MEMORY_SCOPE_AGENT); }
__device__ __forceinline__ unsigned xb_xcc_id() { return (unsigned)__builtin_amdgcn_s_getreg((3 << 11) | 20) & 0xFu; }
#define XB_SPIN(cond, bar) do { unsigned _sp = 0; while (cond) { __builtin_amdgcn_s_sleep(1); \
    if ((++_sp & 255u) == 0u) { if (xb_ld(&(bar)[XB_TMO])) break; if (_sp > XB_SPIN_CAP) { atomicAdd(&(bar)[XB_TMO], 1u); break; } } } } while (0)

struct XcdBarrier {
    unsigned* bar; unsigned x;
    volatile LAS unsigned* st;
};

__device__ __forceinline__ XcdBarrier xcd_barrier_post(unsigned* bar, volatile LAS unsigned* st) {
    XcdBarrier b; b.bar = bar; b.x = xb_xcc_id(); b.st = st;
    if (threadIdx.x == 0) (void)xb_add(&bar[XB_XCNT(b.x)], 1u);
    return b;
}
__device__ __forceinline__ void xcd_barrier_complete(unsigned* bar, unsigned x, unsigned& nloc, unsigned& nx) {
    const unsigned G = gridDim.x * gridDim.y * gridDim.z;
    unsigned sum, cnt, mine, sp = 0u;
    for (;;) {
        sum = 0u; cnt = 0u; mine = 0u;
#pragma unroll
        for (unsigned j = 0; j < 16; ++j) { const unsigned c = xb_ld(&bar[XB_XCNT(j)]); sum += c; cnt += (c > 0u) ? 1u : 0u; mine = (j == x) ? c : mine; }
        if (sum == G) break;
        __builtin_amdgcn_s_sleep(1);
        if ((++sp & 255u) == 0u) { if (xb_ld(&bar[XB_TMO])) break; if (sp > XB_SPIN_CAP) { atomicAdd(&bar[XB_TMO], 1u); break; } }
    }
    nloc = mine > 0u ? mine : 1u; nx = cnt > 0u ? cnt : 1u;
}

__device__ __forceinline__ void xcd_barrier(const XcdBarrier& b) {
    asm volatile("s_waitcnt vmcnt(0)" ::: "memory");
    __syncthreads();
    if (threadIdx.x == 0) {
        unsigned* bar = b.bar;
        __builtin_amdgcn_s_waitcnt(0);
        unsigned nloc = b.st[0], nx = b.st[1];
        if (nloc == 0u) { xcd_barrier_complete(bar, b.x, nloc, nx); b.st[0] = nloc; b.st[1] = nx; }
        const unsigned old = xb_add(&bar[XB_XSUB(b.x)], 1u);
        const unsigned gen = old / nloc;
        if (old + 1u == (gen + 1u) * nloc) {
            __builtin_amdgcn_fence(__ATOMIC_RELEASE, "agent");
            asm volatile("s_waitcnt vmcnt(0)" ::: "memory");
            const unsigned og = xb_add(&bar[XB_TOP], 1u);
            const unsigned tg = og / nx;
            if (og + 1u == (tg + 1u) * nx) xb_add(&bar[XB_TOPGEN], 1u);
            else XB_SPIN(xb_ld(&bar[XB_TOPGEN]) == tg, bar);
            __builtin_amdgcn_fence(__ATOMIC_ACQUIRE, "agent");
            xb_add(&bar[XB_XGEN(b.x)], 1u);
            asm volatile("s_waitcnt vmcnt(0)" ::: "memory");
        } else {
            XB_SPIN(xb_ld(&bar[XB_XGEN(b.x)]) == gen, bar);
            __builtin_amdgcn_fence(__ATOMIC_ACQUIRE, "agent");
            asm volatile("s_waitcnt vmcnt(0)" ::: "memory");
        }
    }
    __syncthreads();
}

struct Args { const float* in[N_IN]; float* out; unsigned char* ws; int ph_lo, ph_hi; };
struct Frame {
    LAS unsigned char* lds;
    volatile LAS unsigned* MISC;
    gu32* ctl;
    int tid, lane, wave, vcu, G;
};

__device__ __forceinline__ void transpose_item(const float* W, int ldw, int c0, int k0, bf16* WT, int ldt, int r0, float s, LAS float* scr, int lane) {
#pragma unroll 8
    for (int i = 0; i < 32; ++i) { const int kk = 2 * i + (lane >> 5); scr[kk * 33 + (lane & 31)] = W[(size_t)(k0 + kk) * ldw + c0 + (lane & 31)]; }
    LDS_WAIT(); asm volatile("" ::: "memory");
    const int c = lane & 7;
#pragma unroll
    for (int j = 0; j < 4; ++j) { const int n = (lane >> 3) + 8 * j; const LAS float* p = scr + (8 * c) * 33 + n;
        v4u o; o.x = pk2(p[0 * 33] * s, p[1 * 33] * s); o.y = pk2(p[2 * 33] * s, p[3 * 33] * s); o.z = pk2(p[4 * 33] * s, p[5 * 33] * s); o.w = pk2(p[6 * 33] * s, p[7 * 33] * s);
        *(GAS v4u*)(WT + (size_t)(r0 + n) * ldt + k0 + 8 * c) = o; }
    LDS_WAIT(); asm volatile("" ::: "memory");
}
__device__ __forceinline__ void ada_item(const Args& a, Frame& F, int item) {
    const int nt = item % 48, ks = item / 48, n0 = nt * 64, k0 = ks * 256;
    LAS float* sc = (LAS float*)F.lds;
    LAS float* red = sc + 34 * 256;
    for (int i = F.tid; i < 34 * 256; i += NTHREADS) { const int b = i >> 8, k = i & 255;
        const float c = (b < 2) ? a.in[I_CP][b * 1024 + k0 + k] : a.in[I_CS][(b - 2) * 1024 + k0 + k];
        sc[i] = siluf_(c); }
    __syncthreads();
    const int cl = F.tid & 63, kg = F.tid >> 6;
    float acc[34];
#pragma unroll
    for (int b = 0; b < 34; ++b) acc[b] = 0.f;
    const float* w = a.in[I_WADA] + (size_t)(k0 + kg * 32) * 3072 + n0 + cl;
    for (int kk = 0; kk < 32; kk += 4) {
        const float w0 = w[(size_t)(kk + 0) * 3072], w1 = w[(size_t)(kk + 1) * 3072], w2 = w[(size_t)(kk + 2) * 3072], w3 = w[(size_t)(kk + 3) * 3072];
#pragma unroll
        for (int b = 0; b < 34; ++b) { const f32x4 s = *(const LAS f32x4*)(sc + b * 256 + kg * 32 + kk); acc[b] += s.x * w0 + s.y * w1 + s.z * w2 + s.w * w3; }
    }
#pragma unroll
    for (int b = 0; b < 34; ++b) red[(kg * 34 + b) * 64 + cl] = acc[b];
    __syncthreads();
    float* adap = (float*)(a.ws + WS_ADAP);
    for (int i = F.tid; i < 34 * 64; i += NTHREADS) { const int b = i >> 6, c = i & 63; float s = 0.f;
#pragma unroll
        for (int g = 0; g < 8; ++g) s += red[(g * 34 + b) * 64 + c];
        adap[(size_t)(ks * 34 + b) * 3072 + n0 + c] = s; }
    __syncthreads();
}
constexpr int CP_ROWS0 = DBS * 120, CP_ROWS1 = DBS * 504, CP_ROWS2 = DBS * 2040, CP_ROWS = CP_ROWS0 + CP_ROWS1 + CP_ROWS2;
__device__ __forceinline__ void p0_prologue(const Args& a, Frame& F) {
    if (F.vcu < 192) ada_item(a, F, F.vcu);
    LAS float* scr = (LAS float*)(F.lds + F.wave * 16384);
    const int gw = F.vcu * NWAVES + F.wave, NGW = F.G * NWAVES;
    constexpr int I_IN = 16 * 320, I_QK = 128, I_PA = 8 * 32, I_PM = 16 * 32, I_OUT = 16 * 32, NITEMS = I_IN + I_QK + I_PA + I_PM + I_OUT;
    for (int it = gw; it < NITEMS; it += NGW) {
        int r = it;
        if (r < I_IN) { const int kb = r / 320, nb = r % 320; const int c0 = 32 * nb + (32 * nb >= 8192 ? 8 : 0);
            transpose_item(a.in[I_WIN], PROJ_W, c0, 64 * kb, (bf16*)(a.ws + WS_WIN), 1024, 32 * nb, 1.f, scr, F.lane); continue; } r -= I_IN;
        if (r < I_QK) { const int isk = r >> 6, hd = (r >> 4) & 3, kb = (r >> 2) & 3, nb = r & 3;
            transpose_item(a.in[isk ? I_WMK : I_WMQ] + (size_t)hd * 256 * 128, 128, 32 * nb, 64 * kb, (bf16*)(a.ws + WS_WQK), 256, hd * 256 + isk * 128 + 32 * nb, isk ? 1.f : 0.08838834764831845f, scr, F.lane); continue; } r -= I_QK;
        if (r < I_PA) { const int kb = r / 32, nb = r % 32; transpose_item(a.in[I_WPA], 1024, 32 * nb, 64 * kb, (bf16*)(a.ws + WS_WPA), 512, 32 * nb, 1.f, scr, F.lane); continue; } r -= I_PA;
        if (r < I_PM) { const int kb = r / 32, nb = r % 32; transpose_item(a.in[I_WPM], 1024, 32 * nb, 64 * kb, (bf16*)(a.ws + WS_WPM), 1024, 32 * nb, 1.f, scr, F.lane); continue; } r -= I_PM;
        { const int kb = r / 32, nb = r % 32; transpose_item(a.in[I_WOUT], 1024, 32 * nb, 64 * kb, (bf16*)(a.ws + WS_WOUT), 1024, 32 * nb, 1.f, scr, F.lane); }
    }
    for (int it = gw; it < CP_ROWS / 4; it += NGW) {
        int row = it * 4; const float* src; float* dst; int Lb, per;
        if (row < CP_ROWS0) { src = a.in[I_KV128]; dst = a.out + O_KV128S; Lb = 128; per = 120; }
        else if (row < CP_ROWS0 + CP_ROWS1) { row -= CP_ROWS0; src = a.in[I_KV512]; dst = a.out + O_KV512S; Lb = 512; per = 504; }
        else { row -= CP_ROWS0 + CP_ROWS1; src = a.in[I_KV2048]; dst = a.out + O_KV2048S; Lb = 2048; per = 2040; }
        const int b = row / per, j = row % per;
        const f32x4* s4 = (const f32x4*)(src + ((size_t)b * Lb + j + 8) * 1024) + F.lane; f32x4* d4 = (f32x4*)(dst + ((size_t)b * Lb + j) * 1024) + F.lane;
        f32x4 v[16];
#pragma unroll
        for (int q = 0; q < 16; ++q) v[q] = __builtin_nontemporal_load(s4 + 64 * q);
#pragma unroll
        for (int q = 0; q < 16; ++q) __builtin_nontemporal_store(v[q], d4 + 64 * q);
    }
}

__device__ __forceinline__ void p1_hprep(const Args& a, Frame& F) {
    LAS float* mod = (LAS float*)F.lds;
    LAS float* W8 = mod + 4096;
    const float* adap = (const float*)(a.ws + WS_ADAP); const float* bada = a.in[I_BADA];
    for (int i = F.tid; i < 4096; i += NTHREADS) { const int b = i >> 11, which = (i >> 10) & 1, e = i & 1023; const int n = (which == 0 ? 1024 : 0) + e;
        float s = bada[n];
#pragma unroll
        for (int ks = 0; ks < 4; ++ks) s += adap[(size_t)(ks * 34 + b) * 3072 + n];
        mod[i] = which == 0 ? 1.f + s : s; }
    for (int i = F.tid; i < 8192; i += NTHREADS) { const int e = i >> 3, c = i & 7; W8[i] = a.in[I_WIN][(size_t)e * PROJ_W + 8192 + c]; }
    float* gate = (float*)(a.ws + WS_GATE);
    for (int i = F.vcu * NTHREADS + F.tid; i < NBATCH * 1024; i += F.G * NTHREADS) { const int b = i >> 10, n = 2048 + (i & 1023); float s = bada[n];
#pragma unroll
        for (int ks = 0; ks < 4; ++ks) s += adap[(size_t)(ks * 34 + b) * 3072 + n];
        gate[i] = s; }
    __syncthreads();
    const int gw = F.vcu * NWAVES + F.wave, NGW = F.G * NWAVES;
    const float* ng = a.in[I_NG];
    bf16* HN = (bf16*)(a.ws + WS_HN); float* GT = (float*)(a.ws + WS_GATES);
    for (int r = gw; r < M; r += NGW) {
        const float* xrow = r < MP ? a.in[I_XP] + (size_t)r * 1024 : a.in[I_XS] + (size_t)(r - MP) * 1024;
        f32x4 v[4]; float ssq = 0.f;
#pragma unroll
        for (int j = 0; j < 4; ++j) { v[j] = ((const f32x4*)xrow)[64 * j + F.lane]; ssq += (v[j].x * v[j].x + v[j].y * v[j].y) + (v[j].z * v[j].z + v[j].w * v[j].w); }
        const float rstd = rsqrtf(wave_sum(ssq) * (1.f / 1024.f) + EPS);
        float g[8];
#pragma unroll
        for (int c = 0; c < 8; ++c) g[c] = 0.f;
#pragma unroll
        for (int j = 0; j < 4; ++j) {
            const int e = 4 * (64 * j + F.lane);
            const f32x4 gn = *(const f32x4*)(ng + e);
            f32x4 sc1, sh;
            if (r < MP) { const int b = r >> 13; sc1 = *(const LAS f32x4*)(mod + (b * 2 + 0) * 1024 + e); sh = *(const LAS f32x4*)(mod + (b * 2 + 1) * 1024 + e); }
            else { const int b = 2 + ((r - MP) >> 3); sc1 = *(const f32x4*)(bada + 1024 + e); sh = *(const f32x4*)(bada + e);
#pragma unroll
                for (int ks = 0; ks < 4; ++ks) { sc1 += *(const f32x4*)(adap + (size_t)(ks * 34 + b) * 3072 + 1024 + e); sh += *(const f32x4*)(adap + (size_t)(ks * 34 + b) * 3072 + e); }
                sc1 += 1.f; }
            const f32x4 h = v[j] * rstd * gn * sc1 + sh;
            v2u o; o.x = pk2(h.x, h.y); o.y = pk2(h.z, h.w);
            *(v2u*)(HN + (size_t)r * 1024 + e) = o;
#pragma unroll
            for (int q = 0; q < 4; ++q) { const f32x4 w0 = *(const LAS f32x4*)(W8 + (e + q) * 8), w1 = *(const LAS f32x4*)(W8 + (e + q) * 8 + 4); const float hq = h[q];
                g[0] += hq * w0.x; g[1] += hq * w0.y; g[2] += hq * w0.z; g[3] += hq * w0.w; g[4] += hq * w1.x; g[5] += hq * w1.y; g[6] += hq * w1.z; g[7] += hq * w1.w; }
        }
#pragma unroll
        for (int c = 0; c < 8; ++c) g[c] = wave_sum(g[c]);
        if (F.lane == 0) { *(f32x4*)(GT + (size_t)r * 8) = (f32x4){g[0], g[1], g[2], g[3]}; *(f32x4*)(GT + (size_t)r * 8 + 4) = (f32x4){g[4], g[5], g[6], g[7]}; }
    }
}

struct EpiG1 {
    static constexpr bool PERM = true, AFTER_DRAIN = false;
    unsigned char* ws; float* out;
    template <int ACT> __device__ __forceinline__ void store(const pg8::f32x4 (&acc)[2][2][4][2], bf16* dst, int ldc, int row0, int col0) const {
#pragma unroll
        for (int ai = 0; ai < 2; ++ai)
#pragma unroll
            for (int m = 0; m < 4; ++m) { bf16* rowp = dst + (size_t)(row0 + ai * 128 + m * 16) * ldc + col0;
#pragma unroll
                for (int bj = 0; bj < 2; ++bj) { pg8::f32x4 v0 = acc[ai][bj][m][0], v1 = acc[ai][bj][m][1];
                    if (ACT == 1) {
#pragma unroll
                        for (int q = 0; q < 4; ++q) { v0[q] = siluf_(v0[q]); v1[q] = siluf_(v1[q]); } }
                    if (ACT == 2) {
#pragma unroll
                        for (int q = 0; q < 4; ++q) { v0[q] = sigmoidf_(v0[q]); v1[q] = sigmoidf_(v1[q]); } }
                    v4u w; w.x = pg8::cvt_pk_bf16(v0[0], v0[1]); w.y = pg8::cvt_pk_bf16(v0[2], v0[3]); w.z = pg8::cvt_pk_bf16(v1[0], v1[1]); w.w = pg8::cvt_pk_bf16(v1[2], v1[3]);
                    *(v4u*)(rowp + bj * 128) = w; } }
    }
    __device__ __forceinline__ void operator()(const pg8::f32x4 (&acc)[2][2][4][2], const pg8::Unit& u, int wr, int wc, int fr, int fq) const {
        const int pn = u.pn, row0 = u.pm * 256 + wr * 64 + fr, cin = wc * 32 + 8 * fq;
        if (pn < 18) store<0>(acc, (bf16*)(ws + WS_QKV), 4608, row0, pn * 256 + cin);
        else if (pn < 20) store<1>(acc, (bf16*)(ws + WS_ZA), 512, row0, (pn - 18) * 256 + cin);
        else if (pn < 24) store<0>(acc, (bf16*)(ws + WS_XM), 1024, row0, (pn - 20) * 256 + cin);
        else if (pn < 28) store<1>(acc, (bf16*)(ws + WS_ZM), 1024, row0, (pn - 24) * 256 + cin);
        else if (pn < 32) store<2>(acc, (bf16*)(ws + WS_OM), 1024, row0, (pn - 28) * 256 + cin);
        else if (pn < 36) store<2>(acc, (bf16*)(ws + WS_GA), 1024, row0, (pn - 32) * 256 + cin);
        else store<2>(acc, (bf16*)(ws + WS_GM), 1024, row0, (pn - 36) * 256 + cin);
        if (pn >= 6 && pn < 18) {
            const int isv = (pn - 6) / 6, gi = ((pn - 6) % 6) >> 1, half = (pn - 6) & 1, keep = 128 << (2 * gi);
            const int t0 = (u.pm & 31) * 256;
            if (u.pm == 64 || t0 + 256 > SEQ - keep) {
                float* kvp = out + (gi == 0 ? O_KV128P : gi == 1 ? O_KV512P : O_KV2048P); float* kvs = out + (gi == 0 ? O_KV128S : gi == 1 ? O_KV512S : O_KV2048S);
                const int dcol = isv * 512 + half * 256 + cin;
#pragma unroll
                for (int ai = 0; ai < 2; ++ai)
#pragma unroll
                    for (int m = 0; m < 4; ++m) { const int r = row0 + ai * 128 + m * 16; float* drow = nullptr;
                        if (r < MP) { const int b = r >> 13, t = r & (SEQ - 1); if (t >= SEQ - keep) drow = kvp + ((size_t)b * keep + (t - (SEQ - keep))) * 1024; }
                        else { const int rs = r - MP, b = rs >> 3, t = rs & 7; drow = kvs + ((size_t)b * keep + (keep - 8 + t)) * 1024; }
                        if (drow) {
#pragma unroll
                            for (int bj = 0; bj < 2; ++bj) { *(pg8::f32x4*)(drow + dcol + bj * 128) = acc[ai][bj][m][0]; *(pg8::f32x4*)(drow + dcol + bj * 128 + 4) = acc[ai][bj][m][1]; } } }
            }
        }
        if (pn >= 20 && pn < 24 && (u.pm == 64 || (u.pm & 31) == 31)) {
            const int dcol = (pn - 20) * 256 + cin;
#pragma unroll
            for (int ai = 0; ai < 2; ++ai)
#pragma unroll
                for (int m = 0; m < 4; ++m) { const int r = row0 + ai * 128 + m * 16; float* drow = nullptr;
                    if (r < MP) { const int b = r >> 13, t = r & (SEQ - 1); if (t >= SEQ - 3) drow = out + O_CONVP + ((size_t)b * 3 + (t - (SEQ - 3))) * 1024; }
                    else { const int rs = r - MP, b = rs >> 3, t = rs & 7; if (t >= 5) drow = out + O_CONVS + ((size_t)b * 3 + (t - 5)) * 1024; }
                    if (drow) {
#pragma unroll
                        for (int bj = 0; bj < 2; ++bj) { *(pg8::f32x4*)(drow + dcol + bj * 128) = acc[ai][bj][m][0]; *(pg8::f32x4*)(drow + dcol + bj * 128 + 4) = acc[ai][bj][m][1]; } } }
        }
    }
};

__device__ __forceinline__ void conv_item(const Args& a, Frame& F, int item) {
    const bf16* XM = (const bf16*)(a.ws + WS_XM); bf16* CA = (bf16*)(a.ws + WS_CACT);
    const float* cw = a.in[I_CONVW]; const float* cb = a.in[I_CONVB]; const float* sconv = a.in[I_SCONV];
    const int cc = F.tid & 127, c0 = 8 * cc, rg = F.tid >> 7;
    float w[4][8], bias[8];
#pragma unroll
    for (int j = 0; j < 4; ++j) { const f32x4 x0 = *(const f32x4*)(cw + j * 1024 + c0), x1 = *(const f32x4*)(cw + j * 1024 + c0 + 4);
        w[j][0] = x0.x; w[j][1] = x0.y; w[j][2] = x0.z; w[j][3] = x0.w; w[j][4] = x1.x; w[j][5] = x1.y; w[j][6] = x1.z; w[j][7] = x1.w; }
    { const f32x4 x0 = *(const f32x4*)(cb + c0), x1 = *(const f32x4*)(cb + c0 + 4); bias[0] = x0.x; bias[1] = x0.y; bias[2] = x0.z; bias[3] = x0.w; bias[4] = x1.x; bias[5] = x1.y; bias[6] = x1.z; bias[7] = x1.w; }
    for (int i = 0; i < 16; ++i) {
        const int r = item * 64 + rg * 16 + i;
        int t, bs = 0; const bool samp = r >= MP;
        if (!samp) t = r & (SEQ - 1); else { t = (r - MP) & 7; bs = (r - MP) >> 3; }
        float acc[8];
#pragma unroll
        for (int q = 0; q < 8; ++q) acc[q] = bias[q];
#pragma unroll
        for (int j = 0; j < 4; ++j) {
            const int tp = t - 3 + j;
            float x[8];
            if (tp >= 0) { const v4u u = *(const v4u*)(XM + (size_t)(r - 3 + j) * 1024 + c0);
                x[0] = bflo(u.x); x[1] = bfhi(u.x); x[2] = bflo(u.y); x[3] = bfhi(u.y); x[4] = bflo(u.z); x[5] = bfhi(u.z); x[6] = bflo(u.w); x[7] = bfhi(u.w); }
            else if (samp) { const float* s = sconv + ((size_t)bs * 3 + (3 + tp)) * 1024 + c0; const f32x4 x0 = *(const f32x4*)s, x1 = *(const f32x4*)(s + 4);
                x[0] = x0.x; x[1] = x0.y; x[2] = x0.z; x[3] = x0.w; x[4] = x1.x; x[5] = x1.y; x[6] = x1.z; x[7] = x1.w; }
            else {
#pragma unroll
                for (int q = 0; q < 8; ++q) x[q] = 0.f; }
#pragma unroll
            for (int q = 0; q < 8; ++q) acc[q] += w[j][q] * x[q];
        }
        v4u o; o.x = pk2(siluf_(acc[0]), siluf_(acc[1])); o.y = pk2(siluf_(acc[2]), siluf_(acc[3])); o.z = pk2(siluf_(acc[4]), siluf_(acc[5])); o.w = pk2(siluf_(acc[6]), siluf_(acc[7]));
        *(v4u*)(CA + (size_t)r * 1024 + c0) = o;
    }
}

__device__ __forceinline__ int t5_bucket(int n) {
    if (n < 16) return n;
    int b = 16;
    b += (n >= 22) + (n >= 30) + (n >= 40) + (n >= 54) + (n >= 73) + (n >= 99) + (n >= 134) + (n >= 182) + (n >= 246) + (n >= 332) + (n >= 450) + (n >= 609) + (n >= 825) + (n >= 1117) + (n >= 1513);
    return b;
}

__device__ __forceinline__ void attn_valu_task(const Args& a, Frame& F, int row, int g, int h, LAS float* pscr) {
    const bf16* QKV = (const bf16*)(a.ws + WS_QKV);
    const int d = 1 << (2 * g), Lb = 128 << (2 * g);
    const bool samp = row >= MP;
    const int b = samp ? (row - MP) >> 3 : row >> 13, t = samp ? (row - MP) & 7 : row & (SEQ - 1);
    const float* cache = a.in[g == 0 ? I_KV128 : g == 1 ? I_KV512 : I_KV2048];
    const float* rel = a.in[I_REL];
    const int jj = F.lane >> 2, eq = F.lane & 3;
    float q[16];
    { const bf16* qp = QKV + (size_t)row * 4608 + g * 512 + h * 64 + 16 * eq; const v4u u0 = *(const v4u*)qp, u1 = *(const v4u*)(qp + 8);
      q[0] = bflo(u0.x); q[1] = bfhi(u0.x); q[2] = bflo(u0.y); q[3] = bfhi(u0.y); q[4] = bflo(u0.z); q[5] = bfhi(u0.z); q[6] = bflo(u0.w); q[7] = bfhi(u0.w);
      q[8] = bflo(u1.x); q[9] = bfhi(u1.x); q[10] = bflo(u1.y); q[11] = bfhi(u1.y); q[12] = bflo(u1.z); q[13] = bfhi(u1.z); q[14] = bflo(u1.w); q[15] = bfhi(u1.w); }
    float s[9]; float mx = -INFINITY;
#pragma unroll
    for (int it = 0; it < 9; ++it) {
        const int j = 16 * it + jj; float dot = 0.f; bool valid = j <= 128;
        const int p = (samp ? Lb + t : t) - d * j;
        valid = valid && p >= 0;
        if (valid) {
            if (samp && p < Lb) { const float* kp = cache + (((size_t)b * Lb + p) * 2 + 0) * 512 + h * 64 + 16 * eq;
#pragma unroll
                for (int c = 0; c < 4; ++c) { const f32x4 kv = *(const f32x4*)(kp + 4 * c); dot += q[4 * c] * kv.x + q[4 * c + 1] * kv.y + q[4 * c + 2] * kv.z + q[4 * c + 3] * kv.w; } }
            else { const int krow = samp ? MP + b * 8 + (p - Lb) : b * SEQ + p; const bf16* kp = QKV + (size_t)krow * 4608 + 1536 + g * 512 + h * 64 + 16 * eq; const v4u u0 = *(const v4u*)kp, u1 = *(const v4u*)(kp + 8);
                dot = q[0] * bflo(u0.x) + q[1] * bfhi(u0.x) + q[2] * bflo(u0.y) + q[3] * bfhi(u0.y) + q[4] * bflo(u0.z) + q[5] * bfhi(u0.z) + q[6] * bflo(u0.w) + q[7] * bfhi(u0.w)
                    + q[8] * bflo(u1.x) + q[9] * bfhi(u1.x) + q[10] * bflo(u1.y) + q[11] * bfhi(u1.y) + q[12] * bflo(u1.z) + q[13] * bfhi(u1.z) + q[14] * bflo(u1.w) + q[15] * bfhi(u1.w); }
        }
        dot += __shfl_xor(dot, 1); dot += __shfl_xor(dot, 2);
        const float bias = rel[t5_bucket(d * (j <= 128 ? j : 128)) * 24 + g * 8 + h];
        s[it] = valid ? dot * 0.125f + bias : -INFINITY;
        mx = fmaxf(mx, s[it]);
    }
    mx = wave_max(mx);
    float l = 0.f;
#pragma unroll
    for (int it = 0; it < 9; ++it) { const float p = __expf(s[it] - mx); s[it] = p; if (eq == 0) { l += p; const int j = 16 * it + jj; if (j <= 128) pscr[j] = p; } }
    l = wave_sum(l);
    LDS_WAIT(); asm volatile("" ::: "memory");
    float o = 0.f;
    const int jmax = samp ? 128 : min(128, t / d);
    for (int j = 0; j <= jmax; ++j) {
        const int p = (samp ? Lb + t : t) - d * j; float vv;
        if (samp && p < Lb) vv = cache[(((size_t)b * Lb + p) * 2 + 1) * 512 + h * 64 + F.lane];
        else { const int vrow = samp ? MP + b * 8 + (p - Lb) : b * SEQ + p; vv = bf1(QKV[(size_t)vrow * 4608 + 3072 + g * 512 + h * 64 + F.lane]); }
        o += pscr[j] * vv;
    }
    o *= fast_rcp(l);
    ((bf16*)(a.ws + WS_OG))[(size_t)row * 1536 + g * 512 + h * 64 + F.lane] = (bf16)f2bf(o);
    if (F.lane == 0) ((float*)(a.ws + WS_LSE))[(size_t)row * 24 + g * 8 + h] = mx + __logf(l);
    LDS_WAIT(); asm volatile("" ::: "memory");
}

__device__ __forceinline__ void combine_rows(const Args& a, Frame& F) {
    const bf16* OG = (const bf16*)(a.ws + WS_OG); const float* LSE = (const float*)(a.ws + WS_LSE); const bf16* ZA = (const bf16*)(a.ws + WS_ZA); bf16* A3 = (bf16*)(a.ws + WS_A3);
    for (size_t i = (size_t)F.vcu * NTHREADS + F.tid; i < (size_t)M * 64; i += (size_t)F.G * NTHREADS) {
        const int row = (int)(i >> 6), ch = (int)(i & 63) * 8, h = ch >> 6;
        const float l0 = LSE[(size_t)row * 24 + h], l1 = LSE[(size_t)row * 24 + 8 + h], l2 = LSE[(size_t)row * 24 + 16 + h];
        const float mx = fmaxf(l0, fmaxf(l1, l2)); float a0 = __expf(l0 - mx), a1 = __expf(l1 - mx), a2 = __expf(l2 - mx); const float inv = fast_rcp(a0 + a1 + a2); a0 *= inv; a1 *= inv; a2 *= inv;
        const v4u o0 = *(const v4u*)(OG + (size_t)row * 1536 + ch), o1 = *(const v4u*)(OG + (size_t)row * 1536 + 512 + ch), o2 = *(const v4u*)(OG + (size_t)row * 1536 + 1024 + ch), z = *(const v4u*)(ZA + (size_t)row * 512 + ch);
        v4u r;
#pragma unroll
        for (int q = 0; q < 4; ++q) { const float lo = (a0 * bflo(o0[q]) + a1 * bflo(o1[q]) + a2 * bflo(o2[q])) * bflo(z[q]), hi = (a0 * bfhi(o0[q]) + a1 * bfhi(o1[q]) + a2 * bfhi(o2[q])) * bfhi(z[q]); r[q] = pk2(lo, hi); }
        *(v4u*)(A3 + (size_t)row * 512 + ch) = r;
    }
}

__device__ __forceinline__ void mlstm_recurrent_unit(const Args& a, Frame& F, int row0, int T, int hd, const float* C0, const float* n0, const float* m0p, float* Cout, float* nout, float* mout) {
    const bf16* QM = (const bf16*)(a.ws + WS_QM); const bf16* KM = (const bf16*)(a.ws + WS_KM); const bf16* XM = (const bf16*)(a.ws + WS_XM);
    const bf16* OM = (const bf16*)(a.ws + WS_OM); const bf16* ZM = (const bf16*)(a.ws + WS_ZM); const bf16* CA = (const bf16*)(a.ws + WS_CACT); bf16* A4 = (bf16*)(a.ws + WS_A4);
    const float* GT = (const float*)(a.ws + WS_GATES); const float* bif = a.in[I_BIF];
    LAS float* qs = (LAS float*)F.lds;
    LAS float* ks = qs + 16 * 128;
    LAS float* vs = ks + 16 * 128;
    LAS float* hs = vs + 16 * 256;
    LAS float* gs = hs + 16 * 256;
    const int v = F.tid >> 1, kh = F.tid & 1;
    float C[64], n[64]; float m;
    if (C0) {
#pragma unroll
        for (int c = 0; c < 16; ++c) { const f32x4 x = *(const f32x4*)(C0 + (size_t)v * 128 + 64 * kh + 4 * c); C[4 * c] = x.x; C[4 * c + 1] = x.y; C[4 * c + 2] = x.z; C[4 * c + 3] = x.w; }
#pragma unroll
        for (int c = 0; c < 16; ++c) { const f32x4 x = *(const f32x4*)(n0 + 64 * kh + 4 * c); n[4 * c] = x.x; n[4 * c + 1] = x.y; n[4 * c + 2] = x.z; n[4 * c + 3] = x.w; }
        m = *m0p;
    } else {
#pragma unroll
        for (int c = 0; c < 64; ++c) { C[c] = 0.f; n[c] = 0.f; }
        m = 0.f;
    }
    for (int tb = 0; tb < T; tb += 16) {
        const int nb = min(16, T - tb);
        __syncthreads();
        for (int i = F.tid; i < nb * 128; i += NTHREADS) { const int tt = i >> 7, k = i & 127; const size_t r = (size_t)(row0 + tb + tt);
            qs[tt * 128 + k] = bf1(QM[r * 512 + hd * 128 + k]); ks[tt * 128 + k] = bf1(KM[r * 512 + hd * 128 + k]); }
        for (int i = F.tid; i < nb * 256; i += NTHREADS) { const int tt = i >> 8, vv = i & 255; vs[tt * 256 + vv] = bf1(XM[(size_t)(row0 + tb + tt) * 1024 + hd * 256 + vv]); }
        if (F.tid < nb) { const size_t r = (size_t)(row0 + tb + F.tid); gs[2 * F.tid] = GT[r * 8 + hd] + bif[hd]; gs[2 * F.tid + 1] = logsigmoidf_(GT[r * 8 + 4 + hd] + bif[4 + hd]); }
        __syncthreads();
        for (int tt = 0; tt < nb; ++tt) {
            const float ig = gs[2 * tt], lf = gs[2 * tt + 1];
            const float mn = fmaxf(lf + m, ig), fw = __expf(lf + m - mn), iw = __expf(ig - mn); m = mn;
            const float vv = vs[tt * 256 + v] * iw;
            float num = 0.f, den = 0.f;
#pragma unroll
            for (int c = 0; c < 16; ++c) {
                const f32x4 kk = *(const LAS f32x4*)(ks + tt * 128 + 64 * kh + 4 * c), qq = *(const LAS f32x4*)(qs + tt * 128 + 64 * kh + 4 * c);
#pragma unroll
                for (int e = 0; e < 4; ++e) { C[4 * c + e] = fw * C[4 * c + e] + vv * kk[e]; n[4 * c + e] = fw * n[4 * c + e] + iw * kk[e]; num += C[4 * c + e] * qq[e]; den += n[4 * c + e] * qq[e]; }
            }
            num += __shfl_xor(num, 1); den += __shfl_xor(den, 1);
            const float hh = num / fmaxf(fabsf(den), __expf(-mn));
            if (kh == 0) hs[tt * 256 + v] = hh;
        }
        __syncthreads();
        for (int tt = F.wave; tt < nb; tt += NWAVES) {
            const f32x4 x = *(const LAS f32x4*)(hs + tt * 256 + 4 * F.lane);
            const float mu = wave_sum((x.x + x.y) + (x.z + x.w)) * (1.f / 256.f);
            const f32x4 dx = x - mu;
            const float var = wave_sum((dx.x * dx.x + dx.y * dx.y) + (dx.z * dx.z + dx.w * dx.w)) * (1.f / 256.f);
            const float rs = rsqrtf(var + EPS);
            const size_t r = (size_t)(row0 + tb + tt); const int ch = hd * 256 + 4 * F.lane;
            const v2u om = *(const v2u*)(OM + r * 1024 + ch), zm = *(const v2u*)(ZM + r * 1024 + ch), ca = *(const v2u*)(CA + r * 1024 + ch);
            const f32x4 mnw = *(const f32x4*)(a.in[I_MNORM] + ch), msk = *(const f32x4*)(a.in[I_MSKIP] + ch);
            const float o0 = (bflo(om.x) * (dx.x * rs) * mnw.x + msk.x * bflo(ca.x)) * bflo(zm.x), o1 = (bfhi(om.x) * (dx.y * rs) * mnw.y + msk.y * bfhi(ca.x)) * bfhi(zm.x);
            const float o2 = (bflo(om.y) * (dx.z * rs) * mnw.z + msk.z * bflo(ca.y)) * bflo(zm.y), o3 = (bfhi(om.y) * (dx.w * rs) * mnw.w + msk.w * bfhi(ca.y)) * bfhi(zm.y);
            v2u o; o.x = pk2(o0, o1); o.y = pk2(o2, o3);
            *(v2u*)(A4 + r * 1024 + ch) = o;
        }
    }
#pragma unroll
    for (int c = 0; c < 16; ++c) *(f32x4*)(Cout + (size_t)v * 128 + 64 * kh + 4 * c) = (f32x4){C[4 * c], C[4 * c + 1], C[4 * c + 2], C[4 * c + 3]};
    if (v == 0) {
#pragma unroll
        for (int c = 0; c < 16; ++c) *(f32x4*)(nout + 64 * kh + 4 * c) = (f32x4){n[4 * c], n[4 * c + 1], n[4 * c + 2], n[4 * c + 3]};
        if (kh == 0) *mout = m;
    }
    __syncthreads();
}

struct EpiMQK {
    static constexpr bool PERM = true, AFTER_DRAIN = false;
    unsigned char* ws;
    __device__ __forceinline__ void operator()(const pg8::f32x4 (&acc)[2][2][4][2], const pg8::Unit& u, int wr, int wc, int fr, int fq) const {
        const int row0 = u.pm * 256 + wr * 64 + fr, col = u.pn * 128 + wc * 32 + 8 * fq;
#pragma unroll
        for (int ai = 0; ai < 2; ++ai)
#pragma unroll
            for (int m = 0; m < 4; ++m)
#pragma unroll
                for (int bj = 0; bj < 2; ++bj) { bf16* dst = (bf16*)(ws + (bj ? WS_KM : WS_QM)) + (size_t)(row0 + ai * 128 + m * 16) * 512 + col;
                    const pg8::f32x4 v0 = acc[ai][bj][m][0], v1 = acc[ai][bj][m][1];
                    v4u w; w.x = pg8::cvt_pk_bf16(v0[0], v0[1]); w.y = pg8::cvt_pk_bf16(v0[2], v0[3]); w.z = pg8::cvt_pk_bf16(v1[0], v1[1]); w.w = pg8::cvt_pk_bf16(v1[2], v1[3]);
                    *(v4u*)dst = w; }
    }
};
template <int STAGE> struct EpiBranch {
    static constexpr bool PERM = true, AFTER_DRAIN = false;
    unsigned char* ws;
    __device__ __forceinline__ void operator()(const pg8::f32x4 (&acc)[2][2][4][2], const pg8::Unit& u, int wr, int wc, int fr, int fq) const {
        const int row0 = u.pm * 256 + wr * 64 + fr, col0 = u.pn * 256 + wc * 32 + 8 * fq;
        const bf16* G = (const bf16*)(ws + (STAGE == 0 ? WS_GA : WS_GM)); bf16* PA = (bf16*)(ws + WS_PA); bf16* MR = (bf16*)(ws + WS_MRG);
#pragma unroll
        for (int ai = 0; ai < 2; ++ai)
#pragma unroll
            for (int m = 0; m < 4; ++m)
#pragma unroll
                for (int bj = 0; bj < 2; ++bj) { const size_t off = (size_t)(row0 + ai * 128 + m * 16) * 1024 + col0 + bj * 128;
                    const v4u gg = *(const v4u*)(G + off); const pg8::f32x4 v0 = acc[ai][bj][m][0], v1 = acc[ai][bj][m][1];
                    float r[8] = {v0[0] * bflo(gg.x), v0[1] * bfhi(gg.x), v0[2] * bflo(gg.y), v0[3] * bfhi(gg.y), v1[0] * bflo(gg.z), v1[1] * bfhi(gg.z), v1[2] * bflo(gg.w), v1[3] * bfhi(gg.w)};
                    if (STAGE == 1) { const v4u pp = *(const v4u*)(PA + off); r[0] += bflo(pp.x); r[1] += bfhi(pp.x); r[2] += bflo(pp.y); r[3] += bfhi(pp.y); r[4] += bflo(pp.z); r[5] += bfhi(pp.z); r[6] += bflo(pp.w); r[7] += bfhi(pp.w); }
                    v4u w; w.x = pg8::cvt_pk_bf16(r[0], r[1]); w.y = pg8::cvt_pk_bf16(r[2], r[3]); w.z = pg8::cvt_pk_bf16(r[4], r[5]); w.w = pg8::cvt_pk_bf16(r[6], r[7]);
                    *(v4u*)((STAGE == 0 ? PA : MR) + off) = w; }
    }
};
struct EpiOut {
    static constexpr bool PERM = false, AFTER_DRAIN = false;
    unsigned char* ws; float* out; const float* xp; const float* xs;
    __device__ __forceinline__ void operator()(const pg8::f32x4 (&acc)[2][2][4][2], const pg8::Unit& u, int wr, int wc, int fr, int fq) const {
        const int row0 = u.pm * 256 + wr * 64 + fr, col0 = u.pn * 256 + wc * 32 + 4 * fq;
        const float* gate = (const float*)(ws + WS_GATE); float* SSQ = (float*)(ws + WS_SSQ);
#pragma unroll
        for (int ai = 0; ai < 2; ++ai)
#pragma unroll
            for (int m = 0; m < 4; ++m) { const int r = row0 + ai * 128 + m * 16;
                const int b = r < MP ? (r >> 13) : 2 + ((r - MP) >> 3);
                const float* xrow = r < MP ? xp + (size_t)r * 1024 : xs + (size_t)(r - MP) * 1024;
                float ss = 0.f;
#pragma unroll
                for (int bj = 0; bj < 2; ++bj)
#pragma unroll
                    for (int n = 0; n < 2; ++n) { const int c = col0 + bj * 128 + n * 16;
                        const pg8::f32x4 gv = *(const pg8::f32x4*)(gate + (size_t)b * 1024 + c), xv = *(const pg8::f32x4*)(xrow + c);
                        const pg8::f32x4 y = xv + gv * acc[ai][bj][m][n];
                        ss += (y[0] * y[0] + y[1] * y[1]) + (y[2] * y[2] + y[3] * y[3]);
                        *(pg8::f32x4*)(out + (size_t)r * 1024 + c) = y; }
                ss += __shfl_xor(ss, 16); ss += __shfl_xor(ss, 32);
                if (fq == 0) SSQ[(size_t)r * 16 + u.pn * 4 + wc] = ss; }
    }
};
__device__ __forceinline__ void final_norm(const Args& a, Frame& F) {
    const int gw = F.vcu * NWAVES + F.wave, NGW = F.G * NWAVES; const float* SSQ = (const float*)(a.ws + WS_SSQ); const float* fg = a.in[I_FG];
    for (int r = gw; r < M; r += NGW) {
        float s = F.lane < 16 ? SSQ[(size_t)r * 16 + F.lane] : 0.f; s = wave_sum(s);
        const float rstd = rsqrtf(s * (1.f / 1024.f) + EPS);
        f32x4* row = (f32x4*)(a.out + (size_t)r * 1024);
#pragma unroll
        for (int j = 0; j < 4; ++j) { const f32x4 y = row[64 * j + F.lane], g = *(const f32x4*)(fg + 4 * (64 * j + F.lane)); row[64 * j + F.lane] = y * rstd * g; }
    }
}

#ifndef MK_SPLIT
#define MK_SPLIT 0
#endif
constexpr int N_PHASES = 9;
__global__ void __launch_bounds__(NTHREADS, 2) mk_fwd(Args args) {
    extern __shared__ __attribute__((aligned(16))) unsigned char lds_raw[];
    Frame F;
    F.lds = (LAS unsigned char*)lds_raw;
    F.MISC = (volatile LAS unsigned*)(F.lds + MISC_OFF);
    F.tid = threadIdx.x; F.lane = F.tid & 63; F.wave = __builtin_amdgcn_readfirstlane(F.tid >> 6);
    F.G = gridDim.x; { const int bx = blockIdx.x; F.vcu = (F.G % 8 == 0) ? (bx % 8) * (F.G / 8) + bx / 8 : bx; }
    F.ctl = (gu32*)(args.ws + WS_CTL);
    for (int u = F.tid; u < (LDS_BYTES - LDSCTL_OFF) / 4; u += NTHREADS) ((LAS unsigned*)(F.lds + LDSCTL_OFF))[u] = 0u;
    __syncthreads();
    XcdBarrier bar; bar.bar = (unsigned*)(F.ctl + CW_BAR); bar.x = 0; bar.st = nullptr;
    if (!MK_SPLIT) bar = xcd_barrier_post((unsigned*)(F.ctl + CW_BAR), F.MISC + 8);
    const int lo = args.ph_lo, hi = args.ph_hi;
#ifndef PH_MASK
#define PH_MASK 0xffff
#endif
#define IN(k) (((PH_MASK >> (k)) & 1) && lo <= (k) && (k) < hi)
#define SEAM(k) do { if (IN(k) && IN((k) + 1)) xcd_barrier(bar); } while (0)

    if (IN(0)) { p0_prologue(args, F); } SEAM(0);
    if (IN(1)) { p1_hprep(args, F); } SEAM(1);
    if (IN(2)) {
        pg8::Gemm g{(const pg8::bf16_t*)(args.ws + WS_HN), (const pg8::bf16_t*)(args.ws + WS_WIN), M, NREG, 1024, 1024, 0};
        pg8::StaticOrder S; S.init(M, NREG, F.G, (int)blockIdx.x);
        EpiG1 E{args.ws, args.out};
        pg8::gemm_phase<EpiG1, pg8::StaticOrder, true, true>(F.lds, g, S, E);
    } SEAM(2);
    if (IN(3)) {
        for (int it = F.vcu; it < M / 64; it += F.G) conv_item(args, F, it);
        LAS float* pscr = (LAS float*)(F.lds + F.wave * 1024);
        const int gw = F.vcu * NWAVES + F.wave, NGW = F.G * NWAVES;
        for (int task = gw; task < M * 24; task += NGW) { const int row = task / 24, gh = task % 24; attn_valu_task(args, F, row, gh >> 3, gh & 7, pscr); }
    } SEAM(3);
    if (IN(4)) {
        pg8::Gemm g{(const pg8::bf16_t*)(args.ws + WS_CACT), (const pg8::bf16_t*)(args.ws + WS_WQK), M, 1024, 256, 1024, 256};
        pg8::StaticOrder S; S.init(M, 1024, F.G, (int)blockIdx.x);
        EpiMQK E{args.ws};
        pg8::gemm_phase<EpiMQK, pg8::StaticOrder, true, true>(F.lds, g, S, E);
        combine_rows(args, F);
    } SEAM(4);
    if (IN(5)) {
        for (int it = F.vcu; it < 8 + DBS * 4; it += F.G) {
            if (it < 8) { const int b = it >> 2, hd = it & 3;
                mlstm_recurrent_unit(args, F, b * SEQ, SEQ, hd, nullptr, nullptr, nullptr, args.out + O_CSTP + (size_t)it * 32768, args.out + O_NP + (size_t)it * 128, args.out + O_MP + it); }
            else { const int u = it - 8, b = u >> 2, hd = u & 3;
                mlstm_recurrent_unit(args, F, MP + b * 8, 8, hd, args.in[I_SC] + (size_t)u * 32768, args.in[I_SN] + (size_t)u * 128, args.in[I_SM] + u,
                                     args.out + O_CSTS + (size_t)u * 32768, args.out + O_NS + (size_t)u * 128, args.out + O_MS + u); }
        }
    } SEAM(5);
    if (IN(6)) {
        { pg8::Gemm g{(const pg8::bf16_t*)(args.ws + WS_A3), (const pg8::bf16_t*)(args.ws + WS_WPA), M, 1024, 512, 512, 0};
          pg8::StaticOrder S; S.init(M, 1024, F.G, (int)blockIdx.x); EpiBranch<0> E{args.ws};
          pg8::gemm_phase<EpiBranch<0>, pg8::StaticOrder, true, true>(F.lds, g, S, E); }
        VM_WAIT(); __syncthreads();
        { pg8::Gemm g{(const pg8::bf16_t*)(args.ws + WS_A4), (const pg8::bf16_t*)(args.ws + WS_WPM), M, 1024, 1024, 1024, 0};
          pg8::StaticOrder S; S.init(M, 1024, F.G, (int)blockIdx.x); EpiBranch<1> E{args.ws};
          pg8::gemm_phase<EpiBranch<1>, pg8::StaticOrder, true, true>(F.lds, g, S, E); }
    } SEAM(6);
    if (IN(7)) {
        pg8::Gemm g{(const pg8::bf16_t*)(args.ws + WS_MRG), (const pg8::bf16_t*)(args.ws + WS_WOUT), M, 1024, 1024, 1024, 0};
        pg8::StaticOrder S; S.init(M, 1024, F.G, (int)blockIdx.x); EpiOut E{args.ws, args.out, args.in[I_XP], args.in[I_XS]};
        pg8::gemm_phase<EpiOut, pg8::StaticOrder, true, true>(F.lds, g, S, E);
    } SEAM(7);
    if (IN(8)) final_norm(args, F);
#undef IN
#undef SEAM
}

extern "C" void kernel_launch(void* const* d_in, const int* in_sizes, int n_in, void* d_out, int out_size, void* d_ws, size_t ws_size, hipStream_t stream) {
    static int grid = 0;
    if (grid == 0) {
        if (n_in != N_IN || (size_t)out_size != O_END || ws_size < WS_END) { fprintf(stderr, "kernel_launch: unexpected shapes: n_in %d out %d ws %zu (need %zu)\n", n_in, out_size, ws_size, (size_t)WS_END); grid = -1; return; }
        int dev = 0, cus = 0, per_cu = 0;
        if (hipGetDevice(&dev) != hipSuccess || hipDeviceGetAttribute(&cus, hipDeviceAttributeMultiprocessorCount, dev) != hipSuccess) { grid = -1; return; }
        if (hipFuncSetAttribute((const void*)mk_fwd, hipFuncAttributeMaxDynamicSharedMemorySize, LDS_BYTES) != hipSuccess) { fprintf(stderr, "kernel_launch: hipFuncSetAttribute failed\n"); grid = -1; return; }
        if (hipOccupancyMaxActiveBlocksPerMultiprocessor(&per_cu, (const void*)mk_fwd, NTHREADS, LDS_BYTES) != hipSuccess || per_cu < 1) { fprintf(stderr, "kernel_launch: occupancy query says %d blocks per CU\n", per_cu); (void)hipGetLastError(); grid = -1; return; }
        grid = cus;
    }
    if (grid < 0) return;
    if (hipMemsetAsync((char*)d_ws + WS_CTL, 0, CTL_ZERO_BYTES, stream) != hipSuccess) return;
    Args a{};
    for (int i = 0; i < N_IN; ++i) a.in[i] = (const float*)d_in[i];
    a.out = (float*)d_out; a.ws = (unsigned char*)d_ws;
#if MK_SPLIT
    for (int p = 0; p < N_PHASES; ++p) { a.ph_lo = p; a.ph_hi = p + 1; hipLaunchKernelGGL(mk_fwd, dim3(grid), dim3(NTHREADS), LDS_BYTES, stream, a); }
#else
    a.ph_lo = 0; a.ph_hi = N_PHASES;
    void* kargs[] = {&a};
    hipError_t e = hipLaunchCooperativeKernel((const void*)mk_fwd, dim3(grid), dim3(NTHREADS), kargs, LDS_BYTES, stream);
    if (e != hipSuccess) fprintf(stderr, "kernel_launch: cooperative launch failed: %s (grid %d)\n", hipGetErrorString(e), grid);
#endif
}
```

```cpp
#include <hip/hip_runtime.h>
#include <cstdio>
#include <cstdint>
namespace pg8 {
#define PG8_LAS __attribute__((address_space(3)))
typedef unsigned short bf16_t;
typedef short bf16x8 __attribute__((ext_vector_type(8)));
typedef float f32x4 __attribute__((ext_vector_type(4)));
typedef unsigned u32x4 __attribute__((ext_vector_type(4)));
constexpr int BM = 256, BK = 64, HALF = 128, HTB = HALF * BK * 2  , STAGE_BYTES = 8 * HTB, NXCD = 8, WGM = 8;

__host__ __device__ __forceinline__ int lds_byte(int r, int c) { const int st = (r >> 4) * 2 + (c >> 5), rr = r & 15, cc = c & 31, ob = rr * 64 + cc * 2; return st * 1024 + (ob ^ (((ob >> 9) & 1) << 5)); }
__host__ __device__ __forceinline__ void stage_rc(int b, int& R, int& C) { const int st = b / 1024, sb = b % 1024, swz = sb ^ (((sb >> 9) & 1) << 5); R = (st >> 1) * 16 + swz / 64; C = (st & 1) * 32 + (swz % 64) / 2; }
__host__ __device__ __forceinline__ int perm32(int rho) { const int n = rho >> 4, i = rho & 15; return 8 * (i >> 2) + 4 * n + (i & 3); }

struct Unit { int pm, pn; };
struct Gemm { const bf16_t* A; const bf16_t* Bt; int M, N, K, lda, a_pn_off; };

struct StaticOrder {
    int nM, nN, nwg, G, c;
    __host__ __device__ void init(int M, int N, int G_, int c_) { nM = M / BM; nN = N / BM; nwg = nM * nN; G = G_; c = c_; }
    __host__ __device__ bool next(int i, Unit& u) const {
        const long L = (long)i * G + c; if (L >= nwg) return false;
        int wgid = (int)L; { const int q = nwg / NXCD, r = nwg % NXCD, xcd = wgid % NXCD, off = wgid / NXCD; wgid = (xcd < r ? xcd * (q + 1) : r * (q + 1) + (xcd - r) * q) + off; }
        const int nig = WGM * nN, gid = wgid / nig, fm = gid * WGM, gsz = (nM - fm) < WGM ? (nM - fm) : WGM;
        u.pm = fm + ((wgid % nig) % gsz); u.pn = (wgid % nig) / gsz; return true;
    }
    __device__ __forceinline__ void a_ready(const Unit&) const {}
    __device__ __forceinline__ void done(const Unit&) const {}
};

typedef float cvt_f32x2_t __attribute__((ext_vector_type(2))); typedef __bf16 cvt_bf16x2_t __attribute__((ext_vector_type(2)));
__device__ __forceinline__ unsigned cvt_pk_bf16(float lo, float hi) { cvt_f32x2_t v = {lo, hi}; cvt_bf16x2_t b = __builtin_convertvector(v, cvt_bf16x2_t); return __builtin_bit_cast(unsigned, b); }
template <class Epi, class Sched, bool ALIGN_EPI = false, bool SP2 = false>
__device__ __forceinline__ void gemm_phase(PG8_LAS unsigned char* lds, const Gemm g, const Sched& S, const Epi& E) {
    const int tid = threadIdx.x, wid = __builtin_amdgcn_readfirstlane(tid >> 6), lane = tid & 63, wr = wid >> 2, wc = wid & 3, fr = lane & 15, fq = lane >> 4;
    const int K = g.K, nt = K / BK;
    unsigned voffA[2], voffB[2];
#pragma unroll
    for (int i = 0; i < 2; ++i) { int R, C; stage_rc(tid * 16 + i * 8192, R, C); const int Rb = Epi::PERM ? ((R & ~31) + perm32(R & 31)) : R;
        voffA[i] = (unsigned)(R * g.lda + C) * 2u; voffB[i] = (unsigned)(Rb * K + C) * 2u; }
    const size_t kstep = (size_t)(BK * 2);
    const size_t hstepA = (size_t)HALF * g.lda * 2, hstepB = (size_t)HALF * K * 2;
    const size_t tstepA = 2 * hstepA, tstepB = 2 * hstepB;
    const size_t apn = (size_t)g.a_pn_off * 2;
    const unsigned ldsw = (unsigned)wid * 1024u;
    const int aoff = lds_byte(wr * 64 + fr, fq * 8), boff = lds_byte(wc * 32 + fr, fq * 8);
#define PG8_SA(b, h) (((b) * 2 + (h)) * HTB)
#define PG8_SB(b, h) ((4 + (b) * 2 + (h)) * HTB)
#define PG8_STAGE(bufoff, gbase, voff) do { _Pragma("unroll") for (int _i = 0; _i < 2; ++_i) \
        __builtin_amdgcn_global_load_lds((const unsigned*)((const char*)(gbase) + (voff)[_i]), (PG8_LAS unsigned*)(lds + (bufoff) + ldsw + _i * 8192), 16, 0, 0); } while (0)
#define PG8_LDA(dst, b, h) do { _Pragma("unroll") for (int m = 0; m < 4; ++m) _Pragma("unroll") for (int k = 0; k < 2; ++k) dst[m][k] = *(const PG8_LAS bf16x8*)(lds + PG8_SA(b, h) + aoff + m * 2048 + k * 1024); } while (0)
#define PG8_LDB(dst, b, h) do { _Pragma("unroll") for (int n = 0; n < 2; ++n) _Pragma("unroll") for (int k = 0; k < 2; ++k) dst[n][k] = *(const PG8_LAS bf16x8*)(lds + PG8_SB(b, h) + boff + n * 2048 + k * 1024); } while (0)
#define PG8_MMA(ai, bj, At, Bt) do { __builtin_amdgcn_s_setprio(1); _Pragma("unroll") for (int m = 0; m < 4; ++m) _Pragma("unroll") for (int n = 0; n < 2; ++n) _Pragma("unroll") for (int k = 0; k < 2; ++k) \
        acc[ai][bj][m][n] = __builtin_amdgcn_mfma_f32_16x16x32_bf16(Bt[n][k], At[m][k], acc[ai][bj][m][n], 0, 0, 0); __builtin_amdgcn_s_setprio(0); } while (0)
#define PG8_WAIT_V(n) asm volatile("s_waitcnt vmcnt(" #n ")" ::: "memory")
#define PG8_WAIT_L(n) asm volatile("s_waitcnt lgkmcnt(" #n ")" ::: "memory")
#define PG8_BAR __builtin_amdgcn_s_barrier()
#define PG8_SCHED __builtin_amdgcn_sched_barrier(0)
    Unit cur, nxt; int ui = 0;
    if (!S.next(0, cur)) return;
    f32x4 acc[2][2][4][2];
#pragma unroll
    for (int a = 0; a < 2; ++a)
#pragma unroll
        for (int b = 0; b < 2; ++b)
#pragma unroll
            for (int m = 0; m < 4; ++m)
#pragma unroll
                for (int n = 0; n < 2; ++n) acc[a][b][m][n] = (f32x4){0.f, 0.f, 0.f, 0.f};
    bf16x8 At[4][2], B0[2][2], B1[2][2];
    const char* cA = (const char*)g.A + (size_t)cur.pm * tstepA + (size_t)cur.pn * apn; const char* cB = (const char*)g.Bt + (size_t)cur.pn * tstepB;
    S.a_ready(cur);
    if constexpr (SP2) {
        PG8_STAGE(PG8_SB(0, 0), cB, voffB); PG8_STAGE(PG8_SB(0, 1), cB + hstepB, voffB); PG8_STAGE(PG8_SA(0, 0), cA, voffA); PG8_STAGE(PG8_SA(0, 1), cA + hstepA, voffA);
        if (wr == 1) PG8_BAR;
        PG8_WAIT_V(2); PG8_BAR;
        PG8_STAGE(PG8_SB(1, 0), cB + kstep, voffB); PG8_STAGE(PG8_SA(1, 0), cA + kstep, voffA); PG8_STAGE(PG8_SB(1, 1), cB + hstepB + kstep, voffB);
        PG8_WAIT_V(6); PG8_BAR;
    } else {
        PG8_STAGE(PG8_SB(0, 0), cB, voffB); PG8_STAGE(PG8_SA(0, 0), cA, voffA); PG8_STAGE(PG8_SB(0, 1), cB + hstepB, voffB); PG8_STAGE(PG8_SA(0, 1), cA + hstepA, voffA);
        if (wr == 1) PG8_BAR;
        PG8_WAIT_V(4); PG8_BAR;
        PG8_STAGE(PG8_SB(1, 0), cB + kstep, voffB); PG8_STAGE(PG8_SA(1, 0), cA + kstep, voffA); PG8_STAGE(PG8_SB(1, 1), cB + hstepB + kstep, voffB);
        PG8_WAIT_V(6); PG8_BAR;
    }
    for (;;) {
        const bool has_next = S.next(ui + 1, nxt);
        const char* nA = has_next ? (const char*)g.A + (size_t)nxt.pm * tstepA + (size_t)nxt.pn * apn : cA; const char* nB = has_next ? (const char*)g.Bt + (size_t)nxt.pn * tstepB : cB;
#pragma nounroll
        for (int t = 0; t < nt; t += 2) {
            const bool last = (t == nt - 2);
            const char* a1 = cA + (size_t)(t + 1) * kstep;
            const char* a2 = last ? nA : cA + (size_t)(t + 2) * kstep; const char* b2 = last ? nB : cB + (size_t)(t + 2) * kstep;
            const char* a3 = a2 + kstep; const char* b3 = b2 + kstep;
            if (last && has_next) S.a_ready(nxt);
            if constexpr (SP2) {
            PG8_LDB(B0, 0, 0); PG8_LDB(B1, 0, 1); PG8_SCHED; PG8_LDA(At, 0, 0); PG8_STAGE(PG8_SA(1, 1), a1 + hstepA, voffA);
            PG8_WAIT_V(8); PG8_WAIT_L(0); PG8_BAR; PG8_MMA(0, 0, At, B0); PG8_MMA(0, 1, At, B1); PG8_BAR; PG8_SCHED;
            PG8_LDA(At, 0, 1); PG8_STAGE(PG8_SB(0, 0), b2, voffB); PG8_STAGE(PG8_SB(0, 1), b2 + hstepB, voffB); PG8_STAGE(PG8_SA(0, 0), a2, voffA);
            PG8_WAIT_V(8); PG8_WAIT_L(0); PG8_BAR; PG8_MMA(1, 0, At, B0); PG8_MMA(1, 1, At, B1); PG8_BAR; PG8_SCHED;
            PG8_LDB(B0, 1, 0); PG8_LDB(B1, 1, 1); PG8_SCHED; PG8_LDA(At, 1, 0); PG8_STAGE(PG8_SA(0, 1), a2 + hstepA, voffA);
            PG8_WAIT_V(8); PG8_WAIT_L(0); PG8_BAR; PG8_MMA(0, 0, At, B0); PG8_MMA(0, 1, At, B1); PG8_BAR; PG8_SCHED;
            PG8_LDA(At, 1, 1); PG8_STAGE(PG8_SB(1, 0), b3, voffB); PG8_STAGE(PG8_SB(1, 1), b3 + hstepB, voffB); PG8_STAGE(PG8_SA(1, 0), a3, voffA);
            PG8_WAIT_V(8); PG8_WAIT_L(0); PG8_BAR; PG8_MMA(1, 0, At, B0); PG8_MMA(1, 1, At, B1); PG8_BAR; PG8_SCHED;
            } else {
            PG8_LDB(B0, 0, 0); PG8_SCHED; PG8_LDA(At, 0, 0); PG8_STAGE(PG8_SA(1, 1), a1 + hstepA, voffA);
            PG8_WAIT_L(8); PG8_BAR; PG8_WAIT_L(0); PG8_MMA(0, 0, At, B0); PG8_BAR; PG8_SCHED;
            PG8_LDB(B1, 0, 1); PG8_STAGE(PG8_SB(0, 0), b2, voffB);
            PG8_BAR; PG8_WAIT_L(0); PG8_MMA(0, 1, At, B1); PG8_BAR;
            PG8_LDA(At, 0, 1); PG8_STAGE(PG8_SA(0, 0), a2, voffA);
            PG8_BAR; PG8_WAIT_L(0); PG8_MMA(1, 0, At, B0); PG8_BAR; PG8_SCHED;
            PG8_STAGE(PG8_SB(0, 1), b2 + hstepB, voffB);
            PG8_WAIT_V(6); PG8_BAR; PG8_MMA(1, 1, At, B1); PG8_BAR;
            PG8_LDB(B0, 1, 0); PG8_SCHED; PG8_LDA(At, 1, 0); PG8_STAGE(PG8_SA(0, 1), a2 + hstepA, voffA);
            PG8_WAIT_L(8); PG8_BAR; PG8_WAIT_L(0); PG8_MMA(0, 0, At, B0); PG8_BAR; PG8_SCHED;
            PG8_LDB(B1, 1, 1); PG8_STAGE(PG8_SB(1, 0), b3, voffB);
            PG8_BAR; PG8_WAIT_L(0); PG8_MMA(0, 1, At, B1); PG8_BAR;
            PG8_LDA(At, 1, 1); PG8_STAGE(PG8_SA(1, 0), a3, voffA);
            PG8_BAR; PG8_WAIT_L(0); PG8_MMA(1, 0, At, B0); PG8_BAR; PG8_SCHED;
            PG8_STAGE(PG8_SB(1, 1), b3 + hstepB, voffB);
            PG8_WAIT_V(6); PG8_BAR; PG8_MMA(1, 1, At, B1); PG8_BAR;
            }
        }
        if constexpr (ALIGN_EPI) { if (wr == 0) PG8_BAR; }
        if constexpr (!Epi::AFTER_DRAIN) { E(acc, cur, wr, wc, fr, fq); S.done(cur); }
        if (!has_next) break;
#pragma unroll
        for (int a = 0; a < 2; ++a)
#pragma unroll
            for (int b = 0; b < 2; ++b)
#pragma unroll
                for (int m = 0; m < 4; ++m)
#pragma unroll
                    for (int n = 0; n < 2; ++n) acc[a][b][m][n] = (f32x4){0.f, 0.f, 0.f, 0.f};
        cur = nxt; cA = nA; cB = nB; ++ui;
        if constexpr (ALIGN_EPI) { if (wr == 1) PG8_BAR; }
    }
    PG8_WAIT_V(0);
    if constexpr (!ALIGN_EPI) { if (wr == 0) PG8_BAR; }
    PG8_BAR;
    if constexpr (Epi::AFTER_DRAIN) { E.fused(acc, cur, wr, wc, fr, fq, lds, wid, lane); S.done(cur); }
#undef PG8_SA
#undef PG8_SB
#undef PG8_STAGE
#undef PG8_LDA
#undef PG8_LDB
#undef PG8_MMA
#undef PG8_WAIT_V
#undef PG8_WAIT_L
#undef PG8_BAR
#undef PG8_SCHED
}
}

constexpr int DMODEL = 1024;
constexpr int NBP = 2, SEQ = 8192, MP = NBP * SEQ;
constexpr int DBS = 32, TS = 8, MS = DBS * TS;
constexpr int M = MP + MS;
constexpr int PROJ_W = 10248, NREG = 10240;
constexpr int NBATCH = NBP + DBS;
constexpr float EPS = 1e-6f;
enum { I_XP = 0, I_XS, I_KV128, I_KV512, I_KV2048, I_SCONV, I_SC, I_SN, I_SM, I_CP, I_CS, I_REL, I_NG, I_WADA, I_BADA, I_WIN, I_BIF,
       I_CONVW, I_CONVB, I_WMQ, I_WMK, I_MNORM, I_MSKIP, I_WPA, I_WPM, I_WOUT, I_FG, N_IN };
constexpr size_t O_YP = 0;
constexpr size_t O_YS = O_YP + (size_t)MP * 1024;
constexpr size_t O_KV128P = O_YS + (size_t)MS * 1024;
constexpr size_t O_KV128S = O_KV128P + (size_t)NBP * 128 * 1024;
constexpr size_t O_KV512P = O_KV128S + (size_t)DBS * 128 * 1024;
constexpr size_t O_KV512S = O_KV512P + (size_t)NBP * 512 * 1024;
constexpr size_t O_KV2048P = O_KV512S + (size_t)DBS * 512 * 1024;
constexpr size_t O_KV2048S = O_KV2048P + (size_t)NBP * 2048 * 1024;
constexpr size_t O_CONVP = O_KV2048S + (size_t)DBS * 2048 * 1024;
constexpr size_t O_CONVS = O_CONVP + (size_t)NBP * 3 * 1024;
constexpr size_t O_CSTP = O_CONVS + (size_t)DBS * 3 * 1024;
constexpr size_t O_CSTS = O_CSTP + (size_t)NBP * 4 * 256 * 128;
constexpr size_t O_NP = O_CSTS + (size_t)DBS * 4 * 256 * 128;
constexpr size_t O_NS = O_NP + (size_t)NBP * 4 * 128;
constexpr size_t O_MP = O_NS + (size_t)DBS * 4 * 128;
constexpr size_t O_MS = O_MP + (size_t)NBP * 4;
constexpr size_t O_END = O_MS + (size_t)DBS * 4;

constexpr size_t wsal(size_t x) { return (x + 65535) & ~(size_t)65535; }
constexpr size_t WS_CTL = 0, CTL_ZERO_BYTES = 1u << 20;
constexpr size_t WS_WIN = wsal(WS_CTL + CTL_ZERO_BYTES);
constexpr size_t WS_WQK = wsal(WS_WIN + (size_t)NREG * 1024 * 2);
constexpr size_t WS_WPA = wsal(WS_WQK + (size_t)1024 * 256 * 2);
constexpr size_t WS_WPM = wsal(WS_WPA + (size_t)1024 * 512 * 2);
constexpr size_t WS_WOUT = wsal(WS_WPM + (size_t)1024 * 1024 * 2);
constexpr size_t WS_ADAP = wsal(WS_WOUT + (size_t)1024 * 1024 * 2);
constexpr size_t WS_GATE = wsal(WS_ADAP + (size_t)4 * NBATCH * 3072 * 4);
constexpr size_t WS_GATES = wsal(WS_GATE + (size_t)NBATCH * 1024 * 4);
constexpr size_t WS_HN = wsal(WS_GATES + (size_t)M * 8 * 4);
constexpr size_t WS_QKV = wsal(WS_HN + (size_t)M * 1024 * 2);
constexpr size_t WS_ZA = wsal(WS_QKV + (size_t)M * 4608 * 2);
constexpr size_t WS_XM = wsal(WS_ZA + (size_t)M * 512 * 2);
constexpr size_t WS_ZM = wsal(WS_XM + (size_t)M * 1024 * 2);
constexpr size_t WS_OM = wsal(WS_ZM + (size_t)M * 1024 * 2);
constexpr size_t WS_GA = wsal(WS_OM + (size_t)M * 1024 * 2);
constexpr size_t WS_GM = wsal(WS_GA + (size_t)M * 1024 * 2);
constexpr size_t WS_CACT = wsal(WS_GM + (size_t)M * 1024 * 2);
constexpr size_t WS_QM = wsal(WS_CACT + (size_t)M * 1024 * 2);
constexpr size_t WS_KM = wsal(WS_QM + (size_t)M * 512 * 2);
constexpr size_t WS_OG = wsal(WS_KM + (size_t)M * 512 * 2);
constexpr size_t WS_LSE = wsal(WS_OG + (size_t)M * 1536 * 2);
constexpr size_t WS_A3 = wsal(WS_LSE + (size_t)M * 24 * 4);
constexpr size_t WS_A4 = wsal(WS_A3 + (size_t)M * 512 * 2);
constexpr size_t WS_PA = wsal(WS_A4 + (size_t)M * 1024 * 2);
constexpr size_t WS_MRG = wsal(WS_PA + (size_t)M * 1024 * 2);
constexpr int NCH = 64, LCH = 128, NUNIT = NBP * 4 * NCH;
constexpr size_t WS_DCP = wsal(WS_MRG + (size_t)M * 1024 * 2);
constexpr size_t WS_DNP = wsal(WS_DCP + (size_t)NUNIT * 32768 * 2);
constexpr size_t WS_CHST = wsal(WS_DNP + (size_t)NUNIT * 128 * 4);
constexpr size_t WS_CPREV = wsal(WS_CHST + (size_t)NUNIT * 2 * 4);
constexpr size_t WS_NPREV = wsal(WS_CPREV + (size_t)NUNIT * 32768 * 2);
constexpr size_t WS_MPREV = wsal(WS_NPREV + (size_t)NUNIT * 128 * 4);
constexpr size_t WS_SSQ = wsal(WS_MPREV + (size_t)NUNIT * 4);
constexpr size_t WS_END = wsal(WS_SSQ + (size_t)M * 16 * 4);
constexpr int CW_BAR = 4096;

constexpr int RING_BYTES = 131072, LDSCTL_OFF = RING_BYTES, MISC_OFF = LDSCTL_OFF + 320, LDS_BYTES = 147456;
constexpr int NWAVES = 8, NTHREADS = 512;

#define GAS __attribute__((address_space(1)))
#define LAS __attribute__((address_space(3)))
typedef unsigned short bf16;
typedef unsigned v4u __attribute__((ext_vector_type(4)));
typedef unsigned v2u __attribute__((ext_vector_type(2)));
typedef float f32x4 __attribute__((ext_vector_type(4)));
typedef float f32x16 __attribute__((ext_vector_type(16)));
typedef short bf16x8 __attribute__((ext_vector_type(8)));
typedef short s16x4 __attribute__((ext_vector_type(4)));
typedef GAS unsigned gu32;
#define RLX_AGENT __ATOMIC_RELAXED, __HIP_MEMORY_SCOPE_AGENT
#define LDS_WAIT() asm volatile("s_waitcnt lgkmcnt(0)" ::: "memory")
#define VM_WAIT() asm volatile("s_waitcnt vmcnt(0)" ::: "memory")
__device__ __forceinline__ unsigned f2bf(float f) { unsigned u = __builtin_bit_cast(unsigned, f); return (u + 0x7fffu + ((u >> 16) & 1u)) >> 16; }
__device__ __forceinline__ unsigned pk2(float lo, float hi) { return f2bf(lo) | (f2bf(hi) << 16); }
__device__ __forceinline__ float bflo(unsigned w) { return __builtin_bit_cast(float, w << 16); }
__device__ __forceinline__ float bfhi(unsigned w) { return __builtin_bit_cast(float, w & 0xffff0000u); }
__device__ __forceinline__ float bf1(bf16 h) { return __builtin_bit_cast(float, (unsigned)h << 16); }
__device__ __forceinline__ float fast_rcp(float x) { return __builtin_amdgcn_rcpf(x); }
__device__ __forceinline__ float sigmoidf_(float x) { return fast_rcp(1.f + __expf(-x)); }
__device__ __forceinline__ float siluf_(float x) { return x * sigmoidf_(x); }
__device__ __forceinline__ float logsigmoidf_(float x) { return fminf(x, 0.f) - log1pf(__expf(-fabsf(x))); }
__device__ __forceinline__ float wave_sum(float v) {
#pragma unroll
    for (int o = 1; o < 64; o <<= 1) v += __shfl_xor(v, o);
    return v;
}
__device__ __forceinline__ float wave_max(float v) {
#pragma unroll
    for (int o = 1; o < 64; o <<= 1) v = fmaxf(v, __shfl_xor(v, o));
    return v;
}
#define XB_TMO      128
#define XB_XCNT(j)  (256  + 64 * (j))
#define XB_XSUB(j)  (1280 + 64 * (j))
#define XB_XGEN(j)  (2304 + 64 * (j))
#define XB_TOP      3328
#define XB_TOPGEN   3392
#define XCD_BAR_WORDS 3456
#define XB_SPIN_CAP (1u << 18)

__device__ __forceinline__ unsigned xb_ld(unsigned* p)              { return __hip_atomic_load(p, __ATOMIC_RELAXED, __HIP_MEMORY_SCOPE_AGENT); }
__device__ __forceinline__ unsigned xb_add(unsigned* p, unsigned v) { return __hip_atomic_fetch_add(p, v, __ATOMIC_RELAXED, __HIP_MEMORY_SCOPE_AGENT); }
__device__ __forceinline__ unsigned xb_xcc_id() { return (unsigned)__builtin_amdgcn_s_getreg((3 << 11) | 20) & 0xFu; }
#define XB_SPIN(cond, bar) do { unsigned _sp = 0; while (cond) { __builtin_amdgcn_s_sleep(1); \
    if ((++_sp & 255u) == 0u) { if (xb_ld(&(bar)[XB_TMO])) break; if (_sp > XB_SPIN_CAP) { atomicAdd(&(bar)[XB_TMO], 1u); break; } } } } while (0)

struct XcdBarrier {
    unsigned* bar; unsigned x;
    volatile LAS unsigned* st;
};

__device__ __forceinline__ XcdBarrier xcd_barrier_post(unsigned* bar, volatile LAS unsigned* st) {
    XcdBarrier b; b.bar = bar; b.x = xb_xcc_id(); b.st = st;
    if (threadIdx.x == 0) (void)xb_add(&bar[XB_XCNT(b.x)], 1u);
    return b;
}
__device__ __forceinline__ void xcd_barrier_complete(unsigned* bar, unsigned x, unsigned& nloc, unsigned& nx) {
    const unsigned G = gridDim.x * gridDim.y * gridDim.z;
    unsigned sum, cnt, mine, sp = 0u;
    for (;;) {
        sum = 0u; cnt = 0u; mine = 0u;
#pragma unroll
        for (unsigned j = 0; j < 16; ++j) { const unsigned c = xb_ld(&bar[XB_XCNT(j)]); sum += c; cnt += (c > 0u) ? 1u : 0u; mine = (j == x) ? c : mine; }
        if (sum == G) break;
        __builtin_amdgcn_s_sleep(1);
        if ((++sp & 255u) == 0u) { if (xb_ld(&bar[XB_TMO])) break; if (sp > XB_SPIN_CAP) { atomicAdd(&bar[XB_TMO], 1u); break; } }
    }
    nloc = mine > 0u ? mine : 1u; nx = cnt > 0u ? cnt : 1u;
}

__device__ __forceinline__ void xcd_barrier(const XcdBarrier& b) {
    asm volatile("s_waitcnt vmcnt(0)" ::: "memory");
    __syncthreads();
    if (threadIdx.x == 0) {
        unsigned* bar = b.bar;
        __builtin_amdgcn_s_waitcnt(0);
        unsigned nloc = b.st[0], nx = b.st[1];
        if (nloc == 0u) { xcd_barrier_complete(bar, b.x, nloc, nx); b.st[0] = nloc; b.st[1] = nx; }
        const unsigned old = xb_add(&bar[XB_XSUB(b.x)], 1u);
        const unsigned gen = old / nloc;
        if (old + 1u == (gen + 1u) * nloc) {
            __builtin_amdgcn_fence(__ATOMIC_RELEASE, "agent");
            asm volatile("s_waitcnt vmcnt(0)" ::: "memory");
            const unsigned og = xb_add(&bar[XB_TOP], 1u);
            const unsigned tg = og / nx;
            if (og + 1u == (tg + 1u) * nx) xb_add(&bar[XB_TOPGEN], 1u);
            else XB_SPIN(xb_ld(&bar[XB_TOPGEN]) == tg, bar);
            __builtin_amdgcn_fence(__ATOMIC_ACQUIRE, "agent");
            xb_add(&bar[XB_XGEN(b.x)], 1u);
            asm volatile("s_waitcnt vmcnt(0)" ::: "memory");
        } else {
            XB_SPIN(xb_ld(&bar[XB_XGEN(b.x)]) == gen, bar);
            __builtin_amdgcn_fence(__ATOMIC_ACQUIRE, "agent");
            asm volatile("s_waitcnt vmcnt(0)" ::: "memory");
        }
    }
    __syncthreads();
}

struct Args { const float* in[N_IN]; float* out; unsigned char* ws; int ph_lo, ph_hi; };
struct Frame {
    LAS unsigned char* lds;
    volatile LAS unsigned* MISC;
    gu32* ctl;
    int tid, lane, wave, vcu, G;
};

__device__ __forceinline__ void transpose_item(const float* W, int ldw, int c0, int k0, bf16* WT, int ldt, int r0, float s, LAS float* scr, int lane) {
#pragma unroll 8
    for (int i = 0; i < 32; ++i) { const int kk = 2 * i + (lane >> 5); scr[kk * 33 + (lane & 31)] = W[(size_t)(k0 + kk) * ldw + c0 + (lane & 31)]; }
    LDS_WAIT(); asm volatile("" ::: "memory");
    const int c = lane & 7;
#pragma unroll
    for (int j = 0; j < 4; ++j) { const int n = (lane >> 3) + 8 * j; const LAS float* p = scr + (8 * c) * 33 + n;
        v4u o; o.x = pk2(p[0 * 33] * s, p[1 * 33] * s); o.y = pk2(p[2 * 33] * s, p[3 * 33] * s); o.z = pk2(p[4 * 33] * s, p[5 * 33] * s); o.w = pk2(p[6 * 33] * s, p[7 * 33] * s);
        *(GAS v4u*)(WT + (size_t)(r0 + n) * ldt + k0 + 8 * c) = o; }
    LDS_WAIT(); asm volatile("" ::: "memory");
}
__device__ __forceinline__ void ada_item(const Args& a, Frame& F, int item) {
    const int nt = item % 48, ks = item / 48, n0 = nt * 64, k0 = ks * 256;
    LAS float* sc = (LAS float*)F.lds;
    LAS float* red = sc + 34 * 256;
    for (int i = F.tid; i < 34 * 256; i += NTHREADS) { const int b = i >> 8, k = i & 255;
        const float c = (b < 2) ? a.in[I_CP][b * 1024 + k0 + k] : a.in[I_CS][(b - 2) * 1024 + k0 + k];
        sc[i] = siluf_(c); }
    __syncthreads();
    const int cl = F.tid & 63, kg = F.tid >> 6;
    float acc[34];
#pragma unroll
    for (int b = 0; b < 34; ++b) acc[b] = 0.f;
    const float* w = a.in[I_WADA] + (size_t)(k0 + kg * 32) * 3072 + n0 + cl;
    for (int kk = 0; kk < 32; kk += 4) {
        const float w0 = w[(size_t)(kk + 0) * 3072], w1 = w[(size_t)(kk + 1) * 3072], w2 = w[(size_t)(kk + 2) * 3072], w3 = w[(size_t)(kk + 3) * 3072];
#pragma unroll
        for (int b = 0; b < 34; ++b) { const f32x4 s = *(const LAS f32x4*)(sc + b * 256 + kg * 32 + kk); acc[b] += s.x * w0 + s.y * w1 + s.z * w2 + s.w * w3; }
    }
#pragma unroll
    for (int b = 0; b < 34; ++b) red[(kg * 34 + b) * 64 + cl] = acc[b];
    __syncthreads();
    float* adap = (float*)(a.ws + WS_ADAP);
    for (int i = F.tid; i < 34 * 64; i += NTHREADS) { const int b = i >> 6, c = i & 63; float s = 0.f;
#pragma unroll
        for (int g = 0; g < 8; ++g) s += red[(g * 34 + b) * 64 + c];
        adap[(size_t)(ks * 34 + b) * 3072 + n0 + c] = s; }
    __syncthreads();
}
constexpr int CP_ROWS0 = DBS * 120, CP_ROWS1 = DBS * 504, CP_ROWS2 = DBS * 2040, CP_ROWS = CP_ROWS0 + CP_ROWS1 + CP_ROWS2;
__device__ __forceinline__ void p0_prologue(const Args& a, Frame& F) {
    if (F.vcu < 192) ada_item(a, F, F.vcu);
    LAS float* scr = (LAS float*)(F.lds + F.wave * 16384);
    const int gw = F.vcu * NWAVES + F.wave, NGW = F.G * NWAVES;
    constexpr int I_IN = 16 * 320, I_QK = 128, I_PA = 8 * 32, I_PM = 16 * 32, I_OUT = 16 * 32, NITEMS = I_IN + I_QK + I_PA + I_PM + I_OUT;
    for (int it = gw; it < NITEMS; it += NGW) {
        int r = it;
        if (r < I_IN) { const int kb = r / 320, nb = r % 320; const int c0 = 32 * nb + (32 * nb >= 8192 ? 8 : 0);
            transpose_item(a.in[I_WIN], PROJ_W, c0, 64 * kb, (bf16*)(a.ws + WS_WIN), 1024, 32 * nb, 1.f, scr, F.lane); continue; } r -= I_IN;
        if (r < I_QK) { const int isk = r >> 6, hd = (r >> 4) & 3, kb = (r >> 2) & 3, nb = r & 3;
            transpose_item(a.in[isk ? I_WMK : I_WMQ] + (size_t)hd * 256 * 128, 128, 32 * nb, 64 * kb, (bf16*)(a.ws + WS_WQK), 256, hd * 256 + isk * 128 + 32 * nb, isk ? 1.f : 0.08838834764831845f, scr, F.lane); continue; } r -= I_QK;
        if (r < I_PA) { const int kb = r / 32, nb = r % 32; transpose_item(a.in[I_WPA], 1024, 32 * nb, 64 * kb, (bf16*)(a.ws + WS_WPA), 512, 32 * nb, 1.f, scr, F.lane); continue; } r -= I_PA;
        if (r < I_PM) { const int kb = r / 32, nb = r % 32; transpose_item(a.in[I_WPM], 1024, 32 * nb, 64 * kb, (bf16*)(a.ws + WS_WPM), 1024, 32 * nb, 1.f, scr, F.lane); continue; } r -= I_PM;
        { const int kb = r / 32, nb = r % 32; transpose_item(a.in[I_WOUT], 1024, 32 * nb, 64 * kb, (bf16*)(a.ws + WS_WOUT), 1024, 32 * nb, 1.f, scr, F.lane); }
    }
    for (int it = gw; it < CP_ROWS / 4; it += NGW) {
        int row = it * 4; const float* src; float* dst; int Lb, per;
        if (row < CP_ROWS0) { src = a.in[I_KV128]; dst = a.out + O_KV128S; Lb = 128; per = 120; }
        else if (row < CP_ROWS0 + CP_ROWS1) { row -= CP_ROWS0; src = a.in[I_KV512]; dst = a.out + O_KV512S; Lb = 512; per = 504; }
        else { row -= CP_ROWS0 + CP_ROWS1; src = a.in[I_KV2048]; dst = a.out + O_KV2048S; Lb = 2048; per = 2040; }
        const int b = row / per, j = row % per;
        const f32x4* s4 = (const f32x4*)(src + ((size_t)b * Lb + j + 8) * 1024) + F.lane; f32x4* d4 = (f32x4*)(dst + ((size_t)b * Lb + j) * 1024) + F.lane;
        f32x4 v[16];
#pragma unroll
        for (int q = 0; q < 16; ++q) v[q] = __builtin_nontemporal_load(s4 + 64 * q);
#pragma unroll
        for (int q = 0; q < 16; ++q) __builtin_nontemporal_store(v[q], d4 + 64 * q);
    }
}

__device__ __forceinline__ void p1_hprep(const Args& a, Frame& F) {
    LAS float* mod = (LAS float*)F.lds;
    LAS float* W8 = mod + 4096;
    const float* adap = (const float*)(a.ws + WS_ADAP); const float* bada = a.in[I_BADA];
    for (int i = F.tid; i < 4096; i += NTHREADS) { const int b = i >> 11, which = (i >> 10) & 1, e = i & 1023; const int n = (which == 0 ? 1024 : 0) + e;
        float s = bada[n];
#pragma unroll
        for (int ks = 0; ks < 4; ++ks) s += adap[(size_t)(ks * 34 + b) * 3072 + n];
        mod[i] = which == 0 ? 1.f + s : s; }
    for (int i = F.tid; i < 8192; i += NTHREADS) { const int e = i >> 3, c = i & 7; W8[i] = a.in[I_WIN][(size_t)e * PROJ_W + 8192 + c]; }
    float* gate = (float*)(a.ws + WS_GATE);
    for (int i = F.vcu * NTHREADS + F.tid; i < NBATCH * 1024; i += F.G * NTHREADS) { const int b = i >> 10, n = 2048 + (i & 1023); float s = bada[n];
#pragma unroll
        for (int ks = 0; ks < 4; ++ks) s += adap[(size_t)(ks * 34 + b) * 3072 + n];
        gate[i] = s; }
    __syncthreads();
    const int gw = F.vcu * NWAVES + F.wave, NGW = F.G * NWAVES;
    const float* ng = a.in[I_NG];
    bf16* HN = (bf16*)(a.ws + WS_HN); float* GT = (float*)(a.ws + WS_GATES);
    for (int r = gw; r < M; r += NGW) {
        const float* xrow = r < MP ? a.in[I_XP] + (size_t)r * 1024 : a.in[I_XS] + (size_t)(r - MP) * 1024;
        f32x4 v[4]; float ssq = 0.f;
#pragma unroll
        for (int j = 0; j < 4; ++j) { v[j] = ((const f32x4*)xrow)[64 * j + F.lane]; ssq += (v[j].x * v[j].x + v[j].y * v[j].y) + (v[j].z * v[j].z + v[j].w * v[j].w); }
        const float rstd = rsqrtf(wave_sum(ssq) * (1.f / 1024.f) + EPS);
        float g[8];
#pragma unroll
        for (int c = 0; c < 8; ++c) g[c] = 0.f;
#pragma unroll
        for (int j = 0; j < 4; ++j) {
            const int e = 4 * (64 * j + F.lane);
            const f32x4 gn = *(const f32x4*)(ng + e);
            f32x4 sc1, sh;
            if (r < MP) { const int b = r >> 13; sc1 = *(const LAS f32x4*)(mod + (b * 2 + 0) * 1024 + e); sh = *(const LAS f32x4*)(mod + (b * 2 + 1) * 1024 + e); }
            else { const int b = 2 + ((r - MP) >> 3); sc1 = *(const f32x4*)(bada + 1024 + e); sh = *(const f32x4*)(bada + e);
#pragma unroll
                for (int ks = 0; ks < 4; ++ks) { sc1 += *(const f32x4*)(adap + (size_t)(ks * 34 + b) * 3072 + 1024 + e); sh += *(const f32x4*)(adap + (size_t)(ks * 34 + b) * 3072 + e); }
                sc1 += 1.f; }
            const f32x4 h = v[j] * rstd * gn * sc1 + sh;
            v2u o; o.x = pk2(h.x, h.y); o.y = pk2(h.z, h.w);
            *(v2u*)(HN + (size_t)r * 1024 + e) = o;
#pragma unroll
            for (int q = 0; q < 4; ++q) { const f32x4 w0 = *(const LAS f32x4*)(W8 + (e + q) * 8), w1 = *(const LAS f32x4*)(W8 + (e + q) * 8 + 4); const float hq = h[q];
                g[0] += hq * w0.x; g[1] += hq * w0.y; g[2] += hq * w0.z; g[3] += hq * w0.w; g[4] += hq * w1.x; g[5] += hq * w1.y; g[6] += hq * w1.z; g[7] += hq * w1.w; }
        }
#pragma unroll
        for (int c = 0; c < 8; ++c) g[c] = wave_sum(g[c]);
        if (F.lane == 0) { *(f32x4*)(GT + (size_t)r * 8) = (f32x4){g[0], g[1], g[2], g[3]}; *(f32x4*)(GT + (size_t)r * 8 + 4) = (f32x4){g[4], g[5], g[6], g[7]}; }
    }
}

struct EpiG1 {
    static constexpr bool PERM = true, AFTER_DRAIN = false;
    unsigned char* ws; float* out;
    template <int ACT> __device__ __forceinline__ void store(const pg8::f32x4 (&acc)[2][2][4][2], bf16* dst, int ldc, int row0, int col0) const {
#pragma unroll
        for (int ai = 0; ai < 2; ++ai)
#pragma unroll
            for (int m = 0; m < 4; ++m) { bf16* rowp = dst + (size_t)(row0 + ai * 128 + m * 16) * ldc + col0;
#pragma unroll
                for (int bj = 0; bj < 2; ++bj) { pg8::f32x4 v0 = acc[ai][bj][m][0], v1 = acc[ai][bj][m][1];
                    if (ACT == 1) {
#pragma unroll
                        for (int q = 0; q < 4; ++q) { v0[q] = siluf_(v0[q]); v1[q] = siluf_(v1[q]); } }
                    if (ACT == 2) {
#pragma unroll
                        for (int q = 0; q < 4; ++q) { v0[q] = sigmoidf_(v0[q]); v1[q] = sigmoidf_(v1[q]); } }
                    v4u w; w.x = pg8::cvt_pk_bf16(v0[0], v0[1]); w.y = pg8::cvt_pk_bf16(v0[2], v0[3]); w.z = pg8::cvt_pk_bf16(v1[0], v1[1]); w.w = pg8::cvt_pk_bf16(v1[2], v1[3]);
                    *(v4u*)(rowp + bj * 128) = w; } }
    }
    __device__ __forceinline__ void operator()(const pg8::f32x4 (&acc)[2][2][4][2], const pg8::Unit& u, int wr, int wc, int fr, int fq) const {
        const int pn = u.pn, row0 = u.pm * 256 + wr * 64 + fr, cin = wc * 32 + 8 * fq;
        if (pn < 18) store<0>(acc, (bf16*)(ws + WS_QKV), 4608, row0, pn * 256 + cin);
        else if (pn < 20) store<1>(acc, (bf16*)(ws + WS_ZA), 512, row0, (pn - 18) * 256 + cin);
        else if (pn < 24) store<0>(acc, (bf16*)(ws + WS_XM), 1024, row0, (pn - 20) * 256 + cin);
        else if (pn < 28) store<1>(acc, (bf16*)(ws + WS_ZM), 1024, row0, (pn - 24) * 256 + cin);
        else if (pn < 32) store<2>(acc, (bf16*)(ws + WS_OM), 1024, row0, (pn - 28) * 256 + cin);
        else if (pn < 36) store<2>(acc, (bf16*)(ws + WS_GA), 1024, row0, (pn - 32) * 256 + cin);
        else store<2>(acc, (bf16*)(ws + WS_GM), 1024, row0, (pn - 36) * 256 + cin);
        if (pn >= 6 && pn < 18) {
            const int isv = (pn - 6) / 6, gi = ((pn - 6) % 6) >> 1, half = (pn - 6) & 1, keep = 128 << (2 * gi);
            const int t0 = (u.pm & 31) * 256;
            if (u.pm == 64 || t0 + 256 > SEQ - keep) {
                float* kvp = out + (gi == 0 ? O_KV128P : gi == 1 ? O_KV512P : O_KV2048P); float* kvs = out + (gi == 0 ? O_KV128S : gi == 1 ? O_KV512S : O_KV2048S);
                const int dcol = isv * 512 + half * 256 + cin;
#pragma unroll
                for (int ai = 0; ai < 2; ++ai)
#pragma unroll
                    for (int m = 0; m < 4; ++m) { const int r = row0 + ai * 128 + m * 16; float* drow = nullptr;
                        if (r < MP) { const int b = r >> 13, t = r & (SEQ - 1); if (t >= SEQ - keep) drow = kvp + ((size_t)b * keep + (t - (SEQ - keep))) * 1024; }
                        else { const int rs = r - MP, b = rs >> 3, t = rs & 7; drow = kvs + ((size_t)b * keep + (keep - 8 + t)) * 1024; }
                        if (drow) {
#pragma unroll
                            for (int bj = 0; bj < 2; ++bj) { *(pg8::f32x4*)(drow + dcol + bj * 128) = acc[ai][bj][m][0]; *(pg8::f32x4*)(drow + dcol + bj * 128 + 4) = acc[ai][bj][m][1]; } } }
            }
        }
        if (pn >= 20 && pn < 24 && (u.pm == 64 || (u.pm & 31) == 31)) {
            const int dcol = (pn - 20) * 256 + cin;
#pragma unroll
            for (int ai = 0; ai < 2; ++ai)
#pragma unroll
                for (int m = 0; m < 4; ++m) { const int r = row0 + ai * 128 + m * 16; float* drow = nullptr;
                    if (r < MP) { const int b = r >> 13, t = r & (SEQ - 1); if (t >= SEQ - 3) drow = out + O_CONVP + ((size_t)b * 3 + (t - (SEQ - 3))) * 1024; }
                    else { const int rs = r - MP, b = rs >> 3, t = rs & 7; if (t >= 5) drow = out + O_CONVS + ((size_t)b * 3 + (t - 5)) * 1024; }
                    if (drow) {
#pragma unroll
                        for (int bj = 0; bj < 2; ++bj) { *(pg8::f32x4*)(drow + dcol + bj * 128) = acc[ai][bj][m][0]; *(pg8::f32x4*)(drow + dcol + bj * 128 + 4) = acc[ai][bj][m][1]; } } }
        }
    }
};

__device__ __forceinline__ void conv_item(const Args& a, Frame& F, int item) {
    const bf16* XM = (const bf16*)(a.ws + WS_XM); bf16* CA = (bf16*)(a.ws + WS_CACT);
    const float* cw = a.in[I_CONVW]; const float* cb = a.in[I_CONVB]; const float* sconv = a.in[I_SCONV];
    const int cc = F.tid & 127, c0 = 8 * cc, rg = F.tid >> 7;
    float w[4][8], bias[8];
#pragma unroll
    for (int j = 0; j < 4; ++j) { const f32x4 x0 = *(const f32x4*)(cw + j * 1024 + c0), x1 = *(const f32x4*)(cw + j * 1024 + c0 + 4);
        w[j][0] = x0.x; w[j][1] = x0.y; w[j][2] = x0.z; w[j][3] = x0.w; w[j][4] = x1.x; w[j][5] = x1.y; w[j][6] = x1.z; w[j][7] = x1.w; }
    { const f32x4 x0 = *(const f32x4*)(cb + c0), x1 = *(const f32x4*)(cb + c0 + 4); bias[0] = x0.x; bias[1] = x0.y; bias[2] = x0.z; bias[3] = x0.w; bias[4] = x1.x; bias[5] = x1.y; bias[6] = x1.z; bias[7] = x1.w; }
    for (int i = 0; i < 16; ++i) {
        const int r = item * 64 + rg * 16 + i;
        int t, bs = 0; const bool samp = r >= MP;
        if (!samp) t = r & (SEQ - 1); else { t = (r - MP) & 7; bs = (r - MP) >> 3; }
        float acc[8];
#pragma unroll
        for (int q = 0; q < 8; ++q) acc[q] = bias[q];
#pragma unroll
        for (int j = 0; j < 4; ++j) {
            const int tp = t - 3 + j;
            float x[8];
            if (tp >= 0) { const v4u u = *(const v4u*)(XM + (size_t)(r - 3 + j) * 1024 + c0);
                x[0] = bflo(u.x); x[1] = bfhi(u.x); x[2] = bflo(u.y); x[3] = bfhi(u.y); x[4] = bflo(u.z); x[5] = bfhi(u.z); x[6] = bflo(u.w); x[7] = bfhi(u.w); }
            else if (samp) { const float* s = sconv + ((size_t)bs * 3 + (3 + tp)) * 1024 + c0; const f32x4 x0 = *(const f32x4*)s, x1 = *(const f32x4*)(s + 4);
                x[0] = x0.x; x[1] = x0.y; x[2] = x0.z; x[3] = x0.w; x[4] = x1.x; x[5] = x1.y; x[6] = x1.z; x[7] = x1.w; }
            else {
#pragma unroll
                for (int q = 0; q < 8; ++q) x[q] = 0.f; }
#pragma unroll
            for (int q = 0; q < 8; ++q) acc[q] += w[j][q] * x[q];
        }
        v4u o; o.x = pk2(siluf_(acc[0]), siluf_(acc[1])); o.y = pk2(siluf_(acc[2]), siluf_(acc[3])); o.z = pk2(siluf_(acc[4]), siluf_(acc[5])); o.w = pk2(siluf_(acc[6]), siluf_(acc[7]));
        *(v4u*)(CA + (size_t)r * 1024 + c0) = o;
    }
}

__device__ __forceinline__ int t5_bucket(int n) {
    if (n < 16) return n;
    int b = 16;
    b += (n >= 22) + (n >= 30) + (n >= 40) + (n >= 54) + (n >= 73) + (n >= 99) + (n >= 134) + (n >= 182) + (n >= 246) + (n >= 332) + (n >= 450) + (n >= 609) + (n >= 825) + (n >= 1117) + (n >= 1513);
    return b;
}

__device__ __forceinline__ void attn_valu_task(const Args& a, Frame& F, int row, int g, int h, LAS float* pscr) {
    const bf16* QKV = (const bf16*)(a.ws + WS_QKV);
    const int d = 1 << (2 * g), Lb = 128 << (2 * g);
    const bool samp = row >= MP;
    const int b = samp ? (row - MP) >> 3 : row >> 13, t = samp ? (row - MP) & 7 : row & (SEQ - 1);
    const float* cache = a.in[g == 0 ? I_KV128 : g == 1 ? I_KV512 : I_KV2048];
    const float* rel = a.in[I_REL];
    const int jj = F.lane >> 2, eq = F.lane & 3;
    float q[16];
    { const bf16* qp = QKV + (size_t)row * 4608 + g * 512 + h * 64 + 16 * eq; const v4u u0 = *(const v4u*)qp, u1 = *(const v4u*)(qp + 8);
      q[0] = bflo(u0.x); q[1] = bfhi(u0.x); q[2] = bflo(u0.y); q[3] = bfhi(u0.y); q[4] = bflo(u0.z); q[5] = bfhi(u0.z); q[6] = bflo(u0.w); q[7] = bfhi(u0.w);
      q[8] = bflo(u1.x); q[9] = bfhi(u1.x); q[10] = bflo(u1.y); q[11] = bfhi(u1.y); q[12] = bflo(u1.z); q[13] = bfhi(u1.z); q[14] = bflo(u1.w); q[15] = bfhi(u1.w); }
    float s[9]; float mx = -INFINITY;
#pragma unroll
    for (int it = 0; it < 9; ++it) {
        const int j = 16 * it + jj; float dot = 0.f; bool valid = j <= 128;
        const int p = (samp ? Lb + t : t) - d * j;
        valid = valid && p >= 0;
        if (valid) {
            if (samp && p < Lb) { const float* kp = cache + (((size_t)b * Lb + p) * 2 + 0) * 512 + h * 64 + 16 * eq;
#pragma unroll
                for (int c = 0; c < 4; ++c) { const f32x4 kv = *(const f32x4*)(kp + 4 * c); dot += q[4 * c] * kv.x + q[4 * c + 1] * kv.y + q[4 * c + 2] * kv.z + q[4 * c + 3] * kv.w; } }
            else { const int krow = samp ? MP + b * 8 + (p - Lb) : b * SEQ + p; const bf16* kp = QKV + (size_t)krow * 4608 + 1536 + g * 512 + h * 64 + 16 * eq; const v4u u0 = *(const v4u*)kp, u1 = *(const v4u*)(kp + 8);
                dot = q[0] * bflo(u0.x) + q[1] * bfhi(u0.x) + q[2] * bflo(u0.y) + q[3] * bfhi(u0.y) + q[4] * bflo(u0.z) + q[5] * bfhi(u0.z) + q[6] * bflo(u0.w) + q[7] * bfhi(u0.w)
                    + q[8] * bflo(u1.x) + q[9] * bfhi(u1.x) + q[10] * bflo(u1.y) + q[11] * bfhi(u1.y) + q[12] * bflo(u1.z) + q[13] * bfhi(u1.z) + q[14] * bflo(u1.w) + q[15] * bfhi(u1.w); }
        }
        dot += __shfl_xor(dot, 1); dot += __shfl_xor(dot, 2);
        const float bias = rel[t5_bucket(d * (j <= 128 ? j : 128)) * 24 + g * 8 + h];
        s[it] = valid ? dot * 0.125f + bias : -INFINITY;
        mx = fmaxf(mx, s[it]);
    }
    mx = wave_max(mx);
    float l = 0.f;
#pragma unroll
    for (int it = 0; it < 9; ++it) { const float p = __expf(s[it] - mx); s[it] = p; if (eq == 0) { l += p; const int j = 16 * it + jj; if (j <= 128) pscr[j] = p; } }
    l = wave_sum(l);
    LDS_WAIT(); asm volatile("" ::: "memory");
    float o = 0.f;
    const int jmax = samp ? 128 : min(128, t / d);
    for (int j = 0; j <= jmax; ++j) {
        const int p = (samp ? Lb + t : t) - d * j; float vv;
        if (samp && p < Lb) vv = cache[(((size_t)b * Lb + p) * 2 + 1) * 512 + h * 64 + F.lane];
        else { const int vrow = samp ? MP + b * 8 + (p - Lb) : b * SEQ + p; vv = bf1(QKV[(size_t)vrow * 4608 + 3072 + g * 512 + h * 64 + F.lane]); }
        o += pscr[j] * vv;
    }
    o *= fast_rcp(l);
    ((bf16*)(a.ws + WS_OG))[(size_t)row * 1536 + g * 512 + h * 64 + F.lane] = (bf16)f2bf(o);
    if (F.lane == 0) ((float*)(a.ws + WS_LSE))[(size_t)row * 24 + g * 8 + h] = mx + __logf(l);
    LDS_WAIT(); asm volatile("" ::: "memory");
}

constexpr int AT_K_OFF = 0, AT_KROW = 144, AT_V_OFF = 384 * AT_KROW, AT_VPLANE = 384 * 64, AT_TB_OFF = AT_V_OFF + 2 * AT_VPLANE, AT_LDS_END = AT_TB_OFF + 192 * 4;
static_assert(AT_LDS_END <= RING_BYTES, "attention LDS");
__device__ __forceinline__ int crow(int r, int hi) { return (r & 3) + 8 * (r >> 2) + 4 * hi; }
typedef short v4i16_t __attribute__((ext_vector_type(4)));
__device__ __forceinline__ s16x4 tr_read(const LAS unsigned char* p) { return __builtin_bit_cast(s16x4, __builtin_amdgcn_ds_read_tr16_b64_v4i16((LAS v4i16_t*)p)); }
__device__ __forceinline__ void attn_mfma_unit(const Args& a, Frame& F, int au) {
    const bf16* QKV = (const bf16*)(a.ws + WS_QKV);
    const int pr = au & 31, bgh = au >> 5, h = bgh & 7, bg = bgh >> 3, g = bg % 3, b = bg / 3;
    const int d = 1 << (2 * g), ppr = 32 >> (2 * g), np = pr & (ppr - 1), r = pr >> (5 - 2 * g);
    LAS unsigned char* Kl = F.lds + AT_K_OFF; LAS unsigned char* Vl = F.lds + AT_V_OFF; LAS float* tb = (LAS float*)(F.lds + AT_TB_OFF);
    const size_t colq = (size_t)g * 512 + h * 64;
    __syncthreads();
    for (int i = F.tid; i < 384 * 8; i += NTHREADS) {
        const int c = i >> 3, ch = i & 7, u = 256 * np - 128 + c;
        v4u kv = (v4u){0u, 0u, 0u, 0u}, vv = (v4u){0u, 0u, 0u, 0u};
        if (u >= 0) { const bf16* rp = QKV + ((size_t)b * SEQ + (size_t)u * d + r) * 4608 + colq + 8 * ch; kv = *(const v4u*)(rp + 1536); vv = *(const v4u*)(rp + 3072); }
        *(LAS v4u*)(Kl + c * AT_KROW + ch * 16) = kv;
        *(LAS v4u*)(Vl + (ch >> 2) * AT_VPLANE + c * 64 + (ch & 3) * 16) = vv;
    }
    if (F.tid < 192) { const int dist = 160 - F.tid; tb[F.tid] = (dist >= 0 && dist <= 128) ? a.in[I_REL][t5_bucket(dist * d) * 24 + g * 8 + h] * 1.4426950408889634f : -INFINITY; }
    __syncthreads();
    int l = F.lane; asm volatile("" : "+v"(l));
    const int w = F.wave, i = l & 31, hh = l >> 5;
    const size_t qrow = (size_t)b * SEQ + (size_t)(256 * np + 32 * w + i) * d + r;
    bf16x8 qf[4];
#pragma unroll
    for (int s = 0; s < 4; ++s) qf[s] = *(const bf16x8*)(QKV + qrow * 4608 + colq + 16 * s + 8 * hh);
    f32x16 st[5];
#pragma unroll
    for (int kt = 0; kt < 5; ++kt) {
        f32x16 acc = {0.f, 0.f, 0.f, 0.f, 0.f, 0.f, 0.f, 0.f, 0.f, 0.f, 0.f, 0.f, 0.f, 0.f, 0.f, 0.f};
#pragma unroll
        for (int s = 0; s < 4; ++s) { const bf16x8 kf = *(const LAS bf16x8*)(Kl + (32 * w + 32 * kt + i) * AT_KROW + (16 * s + 8 * hh) * 2); acc = __builtin_amdgcn_mfma_f32_32x32x16_bf16(kf, qf[s], acc, 0, 0, 0); }
        st[kt] = acc;
        __builtin_amdgcn_sched_barrier(0);
    }
    const float C2 = 0.125f * 1.4426950408889634f;
    const LAS float* tbl = tb + (32 - i + 4 * hh);
    float mx = -INFINITY;
#pragma unroll
    for (int kt = 0; kt < 5; ++kt) {
#pragma unroll
        for (int rg = 0; rg < 16; ++rg) { const float x = st[kt][rg] * C2 + tbl[32 * kt + (rg & 3) + 8 * (rg >> 2)]; st[kt][rg] = x; }
    }
    if (np == 0 && w < 4) {
        const int cmin = 128 - 32 * w - 4 * hh;
#pragma unroll
        for (int kt = 0; kt < 4; ++kt)
#pragma unroll
            for (int rg = 0; rg < 16; ++rg) if (32 * kt + (rg & 3) + 8 * (rg >> 2) < cmin) st[kt][rg] = -INFINITY;
    }
#pragma unroll
    for (int kt = 0; kt < 5; ++kt)
#pragma unroll
        for (int rg = 0; rg < 16; ++rg) mx = fmaxf(mx, st[kt][rg]);
    mx = fmaxf(mx, __shfl_xor(mx, 32));
    float lsum = 0.f;
#pragma unroll
    for (int kt = 0; kt < 5; ++kt)
#pragma unroll
        for (int rg = 0; rg < 16; ++rg) { const float p = __builtin_amdgcn_exp2f(st[kt][rg] - mx); st[kt][rg] = p; lsum += p; }
    lsum += __shfl_xor(lsum, 32);
    f32x16 oacc[2];
#pragma unroll
    for (int et = 0; et < 2; ++et) oacc[et] = (f32x16){0.f, 0.f, 0.f, 0.f, 0.f, 0.f, 0.f, 0.f, 0.f, 0.f, 0.f, 0.f, 0.f, 0.f, 0.f, 0.f};
    const int i16 = l & 15, qq = i16 >> 2, pp = i16 & 3, g1 = (l >> 4) & 1;
    const LAS unsigned char* vb = Vl + (32 * w + 4 * hh + qq) * 64 + (16 * g1 + 4 * pp) * 2;
#pragma unroll
    for (int kt = 0; kt < 5; ++kt)
#pragma unroll
        for (int s = 0; s < 2; ++s) {
            v4u pw; pw.x = pg8::cvt_pk_bf16(st[kt][8 * s + 0], st[kt][8 * s + 1]); pw.y = pg8::cvt_pk_bf16(st[kt][8 * s + 2], st[kt][8 * s + 3]);
            pw.z = pg8::cvt_pk_bf16(st[kt][8 * s + 4], st[kt][8 * s + 5]); pw.w = pg8::cvt_pk_bf16(st[kt][8 * s + 6], st[kt][8 * s + 7]);
            const bf16x8 pf = __builtin_bit_cast(bf16x8, pw);
#pragma unroll
            for (int et = 0; et < 2; ++et) {
                const s16x4 lo = tr_read(vb + et * AT_VPLANE + (32 * kt + 16 * s) * 64), hi = tr_read(vb + et * AT_VPLANE + (32 * kt + 16 * s) * 64 + 512);
                const bf16x8 vf = (bf16x8){lo[0], lo[1], lo[2], lo[3], hi[0], hi[1], hi[2], hi[3]};
                oacc[et] = __builtin_amdgcn_mfma_f32_32x32x16_bf16(vf, pf, oacc[et], 0, 0, 0);
            }
            __builtin_amdgcn_sched_barrier(0);
        }
    const float inv = fast_rcp(lsum);
    bf16* orow = (bf16*)(a.ws + WS_OG) + qrow * 1536 + colq;
#pragma unroll
    for (int et = 0; et < 2; ++et)
#pragma unroll
        for (int rg = 0; rg < 4; ++rg) { v2u o; o.x = pg8::cvt_pk_bf16(oacc[et][4 * rg] * inv, oacc[et][4 * rg + 1] * inv); o.y = pg8::cvt_pk_bf16(oacc[et][4 * rg + 2] * inv, oacc[et][4 * rg + 3] * inv);
            *(v2u*)(orow + 32 * et + 8 * rg + 4 * hh) = o; }
    if (hh == 0) ((float*)(a.ws + WS_LSE))[qrow * 24 + g * 8 + h] = (mx + __log2f(lsum)) * 0.6931471805599453f;
}

__device__ __forceinline__ void combine_rows(const Args& a, Frame& F) {
    const bf16* OG = (const bf16*)(a.ws + WS_OG); const float* LSE = (const float*)(a.ws + WS_LSE); const bf16* ZA = (const bf16*)(a.ws + WS_ZA); bf16* A3 = (bf16*)(a.ws + WS_A3);
    for (size_t i = (size_t)F.vcu * NTHREADS + F.tid; i < (size_t)M * 64; i += (size_t)F.G * NTHREADS) {
        const int row = (int)(i >> 6), ch = (int)(i & 63) * 8, h = ch >> 6;
        const float l0 = LSE[(size_t)row * 24 + h], l1 = LSE[(size_t)row * 24 + 8 + h], l2 = LSE[(size_t)row * 24 + 16 + h];
        const float mx = fmaxf(l0, fmaxf(l1, l2)); float a0 = __expf(l0 - mx), a1 = __expf(l1 - mx), a2 = __expf(l2 - mx); const float inv = fast_rcp(a0 + a1 + a2); a0 *= inv; a1 *= inv; a2 *= inv;
        const v4u o0 = *(const v4u*)(OG + (size_t)row * 1536 + ch), o1 = *(const v4u*)(OG + (size_t)row * 1536 + 512 + ch), o2 = *(const v4u*)(OG + (size_t)row * 1536 + 1024 + ch), z = *(const v4u*)(ZA + (size_t)row * 512 + ch);
        v4u r;
#pragma unroll
        for (int q = 0; q < 4; ++q) { const float lo = (a0 * bflo(o0[q]) + a1 * bflo(o1[q]) + a2 * bflo(o2[q])) * bflo(z[q]), hi = (a0 * bfhi(o0[q]) + a1 * bfhi(o1[q]) + a2 * bfhi(o2[q])) * bfhi(z[q]); r[q] = pk2(lo, hi); }
        *(v4u*)(A3 + (size_t)row * 512 + ch) = r;
    }
}

__device__ __forceinline__ void mlstm_recurrent_unit(const Args& a, Frame& F, int row0, int T, int hd, const float* C0, const float* n0, const float* m0p, float* Cout, float* nout, float* mout) {
    const bf16* QM = (const bf16*)(a.ws + WS_QM); const bf16* KM = (const bf16*)(a.ws + WS_KM); const bf16* XM = (const bf16*)(a.ws + WS_XM);
    const bf16* OM = (const bf16*)(a.ws + WS_OM); const bf16* ZM = (const bf16*)(a.ws + WS_ZM); const bf16* CA = (const bf16*)(a.ws + WS_CACT); bf16* A4 = (bf16*)(a.ws + WS_A4);
    const float* GT = (const float*)(a.ws + WS_GATES); const float* bif = a.in[I_BIF];
    LAS float* qs = (LAS float*)F.lds;
    LAS float* ks = qs + 16 * 128;
    LAS float* vs = ks + 16 * 128;
    LAS float* hs = vs + 16 * 256;
    LAS float* gs = hs + 16 * 256;
    const int v = F.tid >> 1, kh = F.tid & 1;
    float C[64], n[64]; float m;
    if (C0) {
#pragma unroll
        for (int c = 0; c < 16; ++c) { const f32x4 x = *(const f32x4*)(C0 + (size_t)v * 128 + 64 * kh + 4 * c); C[4 * c] = x.x; C[4 * c + 1] = x.y; C[4 * c + 2] = x.z; C[4 * c + 3] = x.w; }
#pragma unroll
        for (int c = 0; c < 16; ++c) { const f32x4 x = *(const f32x4*)(n0 + 64 * kh + 4 * c); n[4 * c] = x.x; n[4 * c + 1] = x.y; n[4 * c + 2] = x.z; n[4 * c + 3] = x.w; }
        m = *m0p;
    } else {
#pragma unroll
        for (int c = 0; c < 64; ++c) { C[c] = 0.f; n[c] = 0.f; }
        m = 0.f;
    }
    for (int tb = 0; tb < T; tb += 16) {
        const int nb = min(16, T - tb);
        __syncthreads();
        for (int i = F.tid; i < nb * 128; i += NTHREADS) { const int tt = i >> 7, k = i & 127; const size_t r = (size_t)(row0 + tb + tt);
            qs[tt * 128 + k] = bf1(QM[r * 512 + hd * 128 + k]); ks[tt * 128 + k] = bf1(KM[r * 512 + hd * 128 + k]); }
        for (int i = F.tid; i < nb * 256; i += NTHREADS) { const int tt = i >> 8, vv = i & 255; vs[tt * 256 + vv] = bf1(XM[(size_t)(row0 + tb + tt) * 1024 + hd * 256 + vv]); }
        if (F.tid < nb) { const size_t r = (size_t)(row0 + tb + F.tid); gs[2 * F.tid] = GT[r * 8 + hd] + bif[hd]; gs[2 * F.tid + 1] = logsigmoidf_(GT[r * 8 + 4 + hd] + bif[4 + hd]); }
        __syncthreads();
        for (int tt = 0; tt < nb; ++tt) {
            const float ig = gs[2 * tt], lf = gs[2 * tt + 1];
            const float mn = fmaxf(lf + m, ig), fw = __expf(lf + m - mn), iw = __expf(ig - mn); m = mn;
            const float vv = vs[tt * 256 + v] * iw;
            float num = 0.f, den = 0.f;
#pragma unroll
            for (int c = 0; c < 16; ++c) {
                const f32x4 kk = *(const LAS f32x4*)(ks + tt * 128 + 64 * kh + 4 * c), qq = *(const LAS f32x4*)(qs + tt * 128 + 64 * kh + 4 * c);
#pragma unroll
                for (int e = 0; e < 4; ++e) { C[4 * c + e] = fw * C[4 * c + e] + vv * kk[e]; n[4 * c + e] = fw * n[4 * c + e] + iw * kk[e]; num += C[4 * c + e] * qq[e]; den += n[4 * c + e] * qq[e]; }
            }
            num += __shfl_xor(num, 1); den += __shfl_xor(den, 1);
            const float hh = num / fmaxf(fabsf(den), __expf(-mn));
            if (kh == 0) hs[tt * 256 + v] = hh;
        }
        __syncthreads();
        for (int tt = F.wave; tt < nb; tt += NWAVES) {
            const f32x4 x = *(const LAS f32x4*)(hs + tt * 256 + 4 * F.lane);
            const float mu = wave_sum((x.x + x.y) + (x.z + x.w)) * (1.f / 256.f);
            const f32x4 dx = x - mu;
            const float var = wave_sum((dx.x * dx.x + dx.y * dx.y) + (dx.z * dx.z + dx.w * dx.w)) * (1.f / 256.f);
            const float rs = rsqrtf(var + EPS);
            const size_t r = (size_t)(row0 + tb + tt); const int ch = hd * 256 + 4 * F.lane;
            const v2u om = *(const v2u*)(OM + r * 1024 + ch), zm = *(const v2u*)(ZM + r * 1024 + ch), ca = *(const v2u*)(CA + r * 1024 + ch);
            const f32x4 mnw = *(const f32x4*)(a.in[I_MNORM] + ch), msk = *(const f32x4*)(a.in[I_MSKIP] + ch);
            const float o0 = (bflo(om.x) * (dx.x * rs) * mnw.x + msk.x * bflo(ca.x)) * bflo(zm.x), o1 = (bfhi(om.x) * (dx.y * rs) * mnw.y + msk.y * bfhi(ca.x)) * bfhi(zm.x);
            const float o2 = (bflo(om.y) * (dx.z * rs) * mnw.z + msk.z * bflo(ca.y)) * bflo(zm.y), o3 = (bfhi(om.y) * (dx.w * rs) * mnw.w + msk.w * bfhi(ca.y)) * bfhi(zm.y);
            v2u o; o.x = pk2(o0, o1); o.y = pk2(o2, o3);
            *(v2u*)(A4 + r * 1024 + ch) = o;
        }
    }
#pragma unroll
    for (int c = 0; c < 16; ++c) *(f32x4*)(Cout + (size_t)v * 128 + 64 * kh + 4 * c) = (f32x4){C[4 * c], C[4 * c + 1], C[4 * c + 2], C[4 * c + 3]};
    if (v == 0) {
#pragma unroll
        for (int c = 0; c < 16; ++c) *(f32x4*)(nout + 64 * kh + 4 * c) = (f32x4){n[4 * c], n[4 * c + 1], n[4 * c + 2], n[4 * c + 3]};
        if (kh == 0) *mout = m;
    }
    __syncthreads();
}

constexpr int ML_VP = 0, ML_PLANE = 128 * 64, ML_KP = 8 * ML_PLANE;
constexpr int ML_KROW = 272, ML_ARR = ML_KP + 128 * ML_KROW;
constexpr int ML_HROW = 528;
static_assert(ML_ARR + 6 * 512 + 2048 <= RING_BYTES && 128 * ML_HROW <= ML_ARR, "mLSTM LDS");

__device__ __forceinline__ void ml_gates(const Args& a, Frame& F, int row0, int hd, LAS float* as, LAS float* bs) {
    const float* GT = (const float*)(a.ws + WS_GATES); const float* bif = a.in[I_BIF];
    if (F.tid < 128) { const size_t r = (size_t)(row0 + F.tid); as[F.tid] = GT[r * 8 + hd] + bif[hd]; bs[F.tid] = logsigmoidf_(GT[r * 8 + 4 + hd] + bif[4 + hd]); }
    __syncthreads();
    if (F.tid == 0) { float run = 0.f;
        for (int s = 0; s < 128; ++s) { run += bs[s]; bs[s] = run; as[s] -= run; } }
    __syncthreads();
}

__device__ __forceinline__ void ml_dc_unit(const Args& a, Frame& F, int unit) {
    const int c = unit & 63, bh = unit >> 6, hd = bh & 3, b = bh >> 2, row0 = b * SEQ + c * 128;
    const bf16* XM = (const bf16*)(a.ws + WS_XM); const bf16* KM = (const bf16*)(a.ws + WS_KM);
    LAS float* as = (LAS float*)(F.lds + ML_ARR); LAS float* bs = as + 256; LAS float* wk = as + 384;
    __syncthreads();
    ml_gates(a, F, row0, hd, as, bs);
    float A = -INFINITY;
    for (int s = 0; s < 128; ++s) A = fmaxf(A, as[s]);
    if (F.tid < 128) wk[F.tid] = __expf(as[F.tid] - A);
    if (F.tid == 0) { float* ch = (float*)(a.ws + WS_CHST) + (size_t)unit * 2; ch[0] = bs[127]; ch[1] = A; }
    __syncthreads();
    for (int i = F.tid; i < 128 * 32; i += NTHREADS) { const int s = i >> 5, ch = i & 31; const float w = wk[s];
        const v4u u = *(const v4u*)(XM + (size_t)(row0 + s) * 1024 + hd * 256 + 8 * ch); v4u o;
#pragma unroll
        for (int q = 0; q < 4; ++q) o[q] = pk2(bflo(u[q]) * w, bfhi(u[q]) * w);
        *(LAS v4u*)(F.lds + ML_VP + (ch >> 2) * ML_PLANE + s * 64 + (ch & 3) * 16) = o; }
    for (int i = F.tid; i < 128 * 16; i += NTHREADS) { const int s = i >> 4, ch = i & 15;
        *(LAS v4u*)(F.lds + ML_KP + (ch >> 2) * ML_PLANE + s * 64 + (ch & 3) * 16) = *(const v4u*)(KM + (size_t)(row0 + s) * 512 + hd * 128 + 8 * ch); }
    __syncthreads();
    int l = F.lane; asm volatile("" : "+v"(l));
    const int w = F.wave, hh = l >> 5, i16 = l & 15, qq = i16 >> 2, pp = i16 & 3, g1 = (l >> 4) & 1;
    const LAS unsigned char* tb0 = F.lds + (8 * hh + qq) * 64 + (16 * g1 + 4 * pp) * 2;
    f32x16 acc[4];
#pragma unroll
    for (int kt = 0; kt < 4; ++kt) acc[kt] = (f32x16){0.f, 0.f, 0.f, 0.f, 0.f, 0.f, 0.f, 0.f, 0.f, 0.f, 0.f, 0.f, 0.f, 0.f, 0.f, 0.f};
#pragma unroll
    for (int ks = 0; ks < 8; ++ks) {
        const s16x4 blo = tr_read(tb0 + ML_VP + w * ML_PLANE + ks * 1024), bhi = tr_read(tb0 + ML_VP + w * ML_PLANE + ks * 1024 + 256);
        const bf16x8 vf = (bf16x8){blo[0], blo[1], blo[2], blo[3], bhi[0], bhi[1], bhi[2], bhi[3]};
#pragma unroll
        for (int kt = 0; kt < 4; ++kt) {
            const s16x4 alo = tr_read(tb0 + ML_KP + kt * ML_PLANE + ks * 1024), ahi = tr_read(tb0 + ML_KP + kt * ML_PLANE + ks * 1024 + 256);
            const bf16x8 kf = (bf16x8){alo[0], alo[1], alo[2], alo[3], ahi[0], ahi[1], ahi[2], ahi[3]};
            acc[kt] = __builtin_amdgcn_mfma_f32_32x32x16_bf16(kf, vf, acc[kt], 0, 0, 0);
        }
    }
    bf16* dcp = (bf16*)(a.ws + WS_DCP) + ((size_t)unit * 256 + 32 * w + (l & 31)) * 128;
#pragma unroll
    for (int kt = 0; kt < 4; ++kt)
#pragma unroll
        for (int rg = 0; rg < 4; ++rg) { v2u o; o.x = pg8::cvt_pk_bf16(acc[kt][4 * rg], acc[kt][4 * rg + 1]); o.y = pg8::cvt_pk_bf16(acc[kt][4 * rg + 2], acc[kt][4 * rg + 3]);
            *(v2u*)(dcp + 32 * kt + 8 * rg + 4 * hh) = o; }
    if (F.tid < 128) { const int k = F.tid; float s = 0.f; const LAS bf16* kp = (const LAS bf16*)(F.lds + ML_KP + (k >> 5) * ML_PLANE) + (k & 31);
        for (int t = 0; t < 128; ++t) s += wk[t] * bf1(kp[t * 32]);
        ((float*)(a.ws + WS_DNP))[(size_t)unit * 128 + k] = s; }
}

__device__ __forceinline__ void ml_cscan(const Args& a, Frame& F) {
    LAS float* wC = (LAS float*)F.lds; LAS float* f1 = wC + 64;
    const unsigned* DCP = (const unsigned*)(a.ws + WS_DCP); unsigned* CPV = (unsigned*)(a.ws + WS_CPREV);
    const float* CH = (const float*)(a.ws + WS_CHST);
    for (int blk = F.vcu; blk < 8 * 32; blk += F.G) {
        const int bh = blk >> 5, e2 = (blk & 31) * 512 + F.tid;
        __syncthreads();
        if (F.tid == 0) { float m = 0.f;
            for (int c = 0; c < 64; ++c) { const float bL = CH[(size_t)(bh * 64 + c) * 2], A = CH[(size_t)(bh * 64 + c) * 2 + 1], Ml = fmaxf(m, A);
                wC[c] = __expf(m - Ml); f1[c] = __expf(A - Ml);
                if ((blk & 31) == 0) ((float*)(a.ws + WS_MPREV))[bh * 64 + c] = m;
                m = bL + Ml; }
            if ((blk & 31) == 0) a.out[O_MP + bh] = m; }
        __syncthreads();
        float c0 = 0.f, c1 = 0.f;
#pragma unroll 8
        for (int c = 0; c < 64; ++c) { const size_t off = (size_t)(bh * 64 + c) * 16384 + e2;
            CPV[off] = pk2(c0, c1); const unsigned dd = DCP[off];
            c0 = wC[c] * c0 + f1[c] * bflo(dd); c1 = wC[c] * c1 + f1[c] * bfhi(dd); }
        *(float2*)(a.out + O_CSTP + (size_t)bh * 32768 + 2 * e2) = make_float2(c0, c1);
        if ((blk & 31) == 0 && F.tid < 128) { float n = 0.f; const float* DN = (const float*)(a.ws + WS_DNP); float* NP = (float*)(a.ws + WS_NPREV);
            for (int c = 0; c < 64; ++c) { NP[(size_t)(bh * 64 + c) * 128 + F.tid] = n; n = wC[c] * n + f1[c] * DN[(size_t)(bh * 64 + c) * 128 + F.tid]; }
            a.out[O_NP + bh * 128 + F.tid] = n; }
    }
}

__device__ __forceinline__ void ml_out_unit(const Args& a, Frame& F, int unit) {
    const int c = unit & 63, bh = unit >> 6, hd = bh & 3, b = bh >> 2, row0 = b * SEQ + c * 128;
    const bf16* XM = (const bf16*)(a.ws + WS_XM); const bf16* KM = (const bf16*)(a.ws + WS_KM); const bf16* QM = (const bf16*)(a.ws + WS_QM);
    LAS float* as = (LAS float*)(F.lds + ML_ARR); LAS float* Ms = as + 128; LAS float* bs = as + 256; LAS float* ns = as + 384; LAS float* stt = as + 512;
    __syncthreads();
    ml_gates(a, F, row0, hd, as, bs);
    const float mprev = ((const float*)(a.ws + WS_MPREV))[unit];
    if (F.tid == 0) { float cm = -INFINITY; for (int s = 0; s < 128; ++s) { cm = fmaxf(cm, as[s]); Ms[s] = fmaxf(cm, mprev); } }
    if (F.tid < 128) ns[F.tid] = ((const float*)(a.ws + WS_NPREV))[(size_t)unit * 128 + F.tid];
    for (int i = F.tid; i < 128 * 32; i += NTHREADS) { const int s = i >> 5, ch = i & 31;
        *(LAS v4u*)(F.lds + ML_VP + (ch >> 2) * ML_PLANE + s * 64 + (ch & 3) * 16) = *(const v4u*)(XM + (size_t)(row0 + s) * 1024 + hd * 256 + 8 * ch); }
    for (int i = F.tid; i < 128 * 16; i += NTHREADS) { const int s = i >> 4, ch = i & 15;
        *(LAS v4u*)(F.lds + ML_KP + s * ML_KROW + ch * 16) = *(const v4u*)(KM + (size_t)(row0 + s) * 512 + hd * 128 + 8 * ch); }
    __syncthreads();
    int l = F.lane; asm volatile("" : "+v"(l));
    const int w = F.wave, tw = w & 3, vh = w >> 2, i = l & 31, hh = l >> 5, i16 = l & 15, qq = i16 >> 2, pp = i16 & 3, g1 = (l >> 4) & 1;
    const int t = 32 * tw + i;
    bf16x8 qf[8];
#pragma unroll
    for (int ks = 0; ks < 8; ++ks) qf[ks] = *(const bf16x8*)(QM + (size_t)(row0 + t) * 512 + hd * 128 + 16 * ks + 8 * hh);
    f32x16 acc[4];
#pragma unroll
    for (int vt = 0; vt < 4; ++vt) acc[vt] = (f32x16){0.f, 0.f, 0.f, 0.f, 0.f, 0.f, 0.f, 0.f, 0.f, 0.f, 0.f, 0.f, 0.f, 0.f, 0.f, 0.f};
    const bf16* cp = (const bf16*)(a.ws + WS_CPREV) + ((size_t)unit * 256 + 128 * vh + i) * 128 + 8 * hh;
#pragma unroll
    for (int vt = 0; vt < 4; ++vt) {
#pragma unroll
        for (int ks = 0; ks < 8; ++ks) { const bf16x8 cf = *(const bf16x8*)(cp + (size_t)vt * 32 * 128 + 16 * ks); acc[vt] = __builtin_amdgcn_mfma_f32_32x32x16_bf16(cf, qf[ks], acc[vt], 0, 0, 0); }
        __builtin_amdgcn_sched_barrier(0);
    }
    float nq = 0.f;
#pragma unroll
    for (int ks = 0; ks < 8; ++ks)
#pragma unroll
        for (int j = 0; j < 8; ++j) nq += ns[16 * ks + 8 * hh + j] * bf1((bf16)qf[ks][j]);
    nq += __shfl_xor(nq, 32);
    const float Mt = Ms[t], winter = __expf(mprev - Mt);
#pragma unroll
    for (int vt = 0; vt < 4; ++vt)
#pragma unroll
        for (int rg = 0; rg < 16; ++rg) acc[vt][rg] *= winter;
    float den = 0.f;
    const LAS unsigned char* kb = F.lds + ML_KP + i * ML_KROW + 8 * hh * 2;
    const LAS unsigned char* vb = F.lds + ML_VP + (4 * vh) * ML_PLANE + (4 * hh + qq) * 64 + (16 * g1 + 4 * pp) * 2;
    const LAS float* asl = as + 4 * hh;
    for (int st = 0; st <= tw; ++st) {
        f32x16 X = {0.f, 0.f, 0.f, 0.f, 0.f, 0.f, 0.f, 0.f, 0.f, 0.f, 0.f, 0.f, 0.f, 0.f, 0.f, 0.f};
#pragma unroll
        for (int ks = 0; ks < 8; ++ks) { const bf16x8 kf = *(const LAS bf16x8*)(kb + st * 32 * ML_KROW + ks * 32); X = __builtin_amdgcn_mfma_f32_32x32x16_bf16(kf, qf[ks], X, 0, 0, 0); }
        const bool diag = st == tw;
#pragma unroll
        for (int rg = 0; rg < 16; ++rg) { const int so = (rg & 3) + 8 * (rg >> 2);
            float wgt = __expf(asl[st * 32 + so] - Mt);
            if (diag && so + 4 * hh > i) wgt = 0.f;
            const float p = X[rg] * wgt; X[rg] = p; den += p; }
#pragma unroll
        for (int s2 = 0; s2 < 2; ++s2) {
            v4u pw; pw.x = pg8::cvt_pk_bf16(X[8 * s2 + 0], X[8 * s2 + 1]); pw.y = pg8::cvt_pk_bf16(X[8 * s2 + 2], X[8 * s2 + 3]); pw.z = pg8::cvt_pk_bf16(X[8 * s2 + 4], X[8 * s2 + 5]); pw.w = pg8::cvt_pk_bf16(X[8 * s2 + 6], X[8 * s2 + 7]);
            const bf16x8 pf = __builtin_bit_cast(bf16x8, pw);
#pragma unroll
            for (int vt = 0; vt < 4; ++vt) {
                const s16x4 lo = tr_read(vb + vt * ML_PLANE + (st * 32 + 16 * s2) * 64), hi = tr_read(vb + vt * ML_PLANE + (st * 32 + 16 * s2) * 64 + 512);
                const bf16x8 vf = (bf16x8){lo[0], lo[1], lo[2], lo[3], hi[0], hi[1], hi[2], hi[3]};
                acc[vt] = __builtin_amdgcn_mfma_f32_32x32x16_bf16(vf, pf, acc[vt], 0, 0, 0);
            }
        }
    }
    den += __shfl_xor(den, 32);
    den += winter * nq;
    const float rden = 1.f / fmaxf(fabsf(den), __expf(-bs[t] - Mt));
    float s1 = 0.f;
#pragma unroll
    for (int vt = 0; vt < 4; ++vt)
#pragma unroll
        for (int rg = 0; rg < 16; ++rg) { acc[vt][rg] *= rden; s1 += acc[vt][rg]; }
    s1 += __shfl_xor(s1, 32);
    if (hh == 0) stt[w * 32 + i] = s1;
    __syncthreads();
    const float mu = (stt[w * 32 + i] + stt[(w ^ 4) * 32 + i]) * (1.f / 256.f);
    float s2v = 0.f;
#pragma unroll
    for (int vt = 0; vt < 4; ++vt)
#pragma unroll
        for (int rg = 0; rg < 16; ++rg) { acc[vt][rg] -= mu; s2v += acc[vt][rg] * acc[vt][rg]; }
    s2v += __shfl_xor(s2v, 32);
    __syncthreads();
    if (hh == 0) stt[w * 32 + i] = s2v;
    __syncthreads();
    const float rs = rsqrtf((stt[w * 32 + i] + stt[(w ^ 4) * 32 + i]) * (1.f / 256.f) + EPS);
    LAS unsigned char* hrow = F.lds + t * ML_HROW + (128 * vh + 4 * hh) * 2;
#pragma unroll
    for (int vt = 0; vt < 4; ++vt)
#pragma unroll
        for (int rg = 0; rg < 4; ++rg) { v2u o; o.x = pg8::cvt_pk_bf16(acc[vt][4 * rg] * rs, acc[vt][4 * rg + 1] * rs); o.y = pg8::cvt_pk_bf16(acc[vt][4 * rg + 2] * rs, acc[vt][4 * rg + 3] * rs);
            *(LAS v2u*)(hrow + (32 * vt + 8 * rg) * 2) = o; }
    __syncthreads();
    const bf16* OM = (const bf16*)(a.ws + WS_OM); const bf16* ZM = (const bf16*)(a.ws + WS_ZM); const bf16* CA = (const bf16*)(a.ws + WS_CACT); bf16* A4 = (bf16*)(a.ws + WS_A4);
    for (int idx = F.tid; idx < 128 * 32; idx += NTHREADS) { const int tt = idx >> 5, ch = idx & 31; const size_t off = (size_t)(row0 + tt) * 1024 + hd * 256 + 8 * ch;
        const v4u hn = *(const LAS v4u*)(F.lds + tt * ML_HROW + ch * 16), om = *(const v4u*)(OM + off), zm = *(const v4u*)(ZM + off), ca = *(const v4u*)(CA + off);
        const f32x4 n0 = *(const f32x4*)(a.in[I_MNORM] + hd * 256 + 8 * ch), n1 = *(const f32x4*)(a.in[I_MNORM] + hd * 256 + 8 * ch + 4), k0 = *(const f32x4*)(a.in[I_MSKIP] + hd * 256 + 8 * ch), k1 = *(const f32x4*)(a.in[I_MSKIP] + hd * 256 + 8 * ch + 4);
        v4u o;
        o.x = pk2((bflo(om.x) * bflo(hn.x) * n0.x + k0.x * bflo(ca.x)) * bflo(zm.x), (bfhi(om.x) * bfhi(hn.x) * n0.y + k0.y * bfhi(ca.x)) * bfhi(zm.x));
        o.y = pk2((bflo(om.y) * bflo(hn.y) * n0.z + k0.z * bflo(ca.y)) * bflo(zm.y), (bfhi(om.y) * bfhi(hn.y) * n0.w + k0.w * bfhi(ca.y)) * bfhi(zm.y));
        o.z = pk2((bflo(om.z) * bflo(hn.z) * n1.x + k1.x * bflo(ca.z)) * bflo(zm.z), (bfhi(om.z) * bfhi(hn.z) * n1.y + k1.y * bfhi(ca.z)) * bfhi(zm.z));
        o.w = pk2((bflo(om.w) * bflo(hn.w) * n1.z + k1.z * bflo(ca.w)) * bflo(zm.w), (bfhi(om.w) * bfhi(hn.w) * n1.w + k1.w * bfhi(ca.w)) * bfhi(zm.w));
        *(v4u*)(A4 + off) = o; }
}

struct EpiMQK {
    static constexpr bool PERM = true, AFTER_DRAIN = false;
    unsigned char* ws;
    __device__ __forceinline__ void operator()(const pg8::f32x4 (&acc)[2][2][4][2], const pg8::Unit& u, int wr, int wc, int fr, int fq) const {
        const int row0 = u.pm * 256 + wr * 64 + fr, col = u.pn * 128 + wc * 32 + 8 * fq;
#pragma unroll
        for (int ai = 0; ai < 2; ++ai)
#pragma unroll
            for (int m = 0; m < 4; ++m)
#pragma unroll
                for (int bj = 0; bj < 2; ++bj) { bf16* dst = (bf16*)(ws + (bj ? WS_KM : WS_QM)) + (size_t)(row0 + ai * 128 + m * 16) * 512 + col;
                    const pg8::f32x4 v0 = acc[ai][bj][m][0], v1 = acc[ai][bj][m][1];
                    v4u w; w.x = pg8::cvt_pk_bf16(v0[0], v0[1]); w.y = pg8::cvt_pk_bf16(v0[2], v0[3]); w.z = pg8::cvt_pk_bf16(v1[0], v1[1]); w.w = pg8::cvt_pk_bf16(v1[2], v1[3]);
                    *(v4u*)dst = w; }
    }
};
template <int STAGE> struct EpiBranch {
    static constexpr bool PERM = true, AFTER_DRAIN = false;
    unsigned char* ws;
    __device__ __forceinline__ void operator()(const pg8::f32x4 (&acc)[2][2][4][2], const pg8::Unit& u, int wr, int wc, int fr, int fq) const {
        const int row0 = u.pm * 256 + wr * 64 + fr, col0 = u.pn * 256 + wc * 32 + 8 * fq;
        const bf16* G = (const bf16*)(ws + (STAGE == 0 ? WS_GA : WS_GM)); bf16* PA = (bf16*)(ws + WS_PA); bf16* MR = (bf16*)(ws + WS_MRG);
#pragma unroll
        for (int ai = 0; ai < 2; ++ai)
#pragma unroll
            for (int m = 0; m < 4; ++m)
#pragma unroll
                for (int bj = 0; bj < 2; ++bj) { const size_t off = (size_t)(row0 + ai * 128 + m * 16) * 1024 + col0 + bj * 128;
                    const v4u gg = *(const v4u*)(G + off); const pg8::f32x4 v0 = acc[ai][bj][m][0], v1 = acc[ai][bj][m][1];
                    float r[8] = {v0[0] * bflo(gg.x), v0[1] * bfhi(gg.x), v0[2] * bflo(gg.y), v0[3] * bfhi(gg.y), v1[0] * bflo(gg.z), v1[1] * bfhi(gg.z), v1[2] * bflo(gg.w), v1[3] * bfhi(gg.w)};
                    if (STAGE == 1) { const v4u pp = *(const v4u*)(PA + off); r[0] += bflo(pp.x); r[1] += bfhi(pp.x); r[2] += bflo(pp.y); r[3] += bfhi(pp.y); r[4] += bflo(pp.z); r[5] += bfhi(pp.z); r[6] += bflo(pp.w); r[7] += bfhi(pp.w); }
                    v4u w; w.x = pg8::cvt_pk_bf16(r[0], r[1]); w.y = pg8::cvt_pk_bf16(r[2], r[3]); w.z = pg8::cvt_pk_bf16(r[4], r[5]); w.w = pg8::cvt_pk_bf16(r[6], r[7]);
                    *(v4u*)((STAGE == 0 ? PA : MR) + off) = w; }
    }
};
struct EpiOut {
    static constexpr bool PERM = false, AFTER_DRAIN = false;
    unsigned char* ws; float* out; const float* xp; const float* xs;
    __device__ __forceinline__ void operator()(const pg8::f32x4 (&acc)[2][2][4][2], const pg8::Unit& u, int wr, int wc, int fr, int fq) const {
        const int row0 = u.pm * 256 + wr * 64 + fr, col0 = u.pn * 256 + wc * 32 + 4 * fq;
        const float* gate = (const float*)(ws + WS_GATE); float* SSQ = (float*)(ws + WS_SSQ);
#pragma unroll
        for (int ai = 0; ai < 2; ++ai)
#pragma unroll
            for (int m = 0; m < 4; ++m) { const int r = row0 + ai * 128 + m * 16;
                const int b = r < MP ? (r >> 13) : 2 + ((r - MP) >> 3);
                const float* xrow = r < MP ? xp + (size_t)r * 1024 : xs + (size_t)(r - MP) * 1024;
                float ss = 0.f;
#pragma unroll
                for (int bj = 0; bj < 2; ++bj)
#pragma unroll
                    for (int n = 0; n < 2; ++n) { const int c = col0 + bj * 128 + n * 16;
                        const pg8::f32x4 gv = *(const pg8::f32x4*)(gate + (size_t)b * 1024 + c), xv = *(const pg8::f32x4*)(xrow + c);
                        const pg8::f32x4 y = xv + gv * acc[ai][bj][m][n];
                        ss += (y[0] * y[0] + y[1] * y[1]) + (y[2] * y[2] + y[3] * y[3]);
                        *(pg8::f32x4*)(out + (size_t)r * 1024 + c) = y; }
                ss += __shfl_xor(ss, 16); ss += __shfl_xor(ss, 32);
                if (fq == 0) SSQ[(size_t)r * 16 + u.pn * 4 + wc] = ss; }
    }
};
__device__ __forceinline__ void final_norm(const Args& a, Frame& F) {
    const int gw = F.vcu * NWAVES + F.wave, NGW = F.G * NWAVES; const float* SSQ = (const float*)(a.ws + WS_SSQ); const float* fg = a.in[I_FG];
    for (int r = gw; r < M; r += NGW) {
        float s = F.lane < 16 ? SSQ[(size_t)r * 16 + F.lane] : 0.f; s = wave_sum(s);
        const float rstd = rsqrtf(s * (1.f / 1024.f) + EPS);
        f32x4* row = (f32x4*)(a.out + (size_t)r * 1024);
#pragma unroll
        for (int j = 0; j < 4; ++j) { const f32x4 y = row[64 * j + F.lane], g = *(const f32x4*)(fg + 4 * (64 * j + F.lane)); row[64 * j + F.lane] = y * rstd * g; }
    }
}

#ifndef MK_SPLIT
#define MK_SPLIT 0
#endif
constexpr int N_PHASES = 11;
__global__ void __launch_bounds__(NTHREADS, 2) mk_fwd(Args args) {
    extern __shared__ __attribute__((aligned(16))) unsigned char lds_raw[];
    Frame F;
    F.lds = (LAS unsigned char*)lds_raw;
    F.MISC = (volatile LAS unsigned*)(F.lds + MISC_OFF);
    F.tid = threadIdx.x; F.lane = F.tid & 63; F.wave = __builtin_amdgcn_readfirstlane(F.tid >> 6);
    F.G = gridDim.x; { const int bx = blockIdx.x; F.vcu = (F.G % 8 == 0) ? (bx % 8) * (F.G / 8) + bx / 8 : bx; }
    F.ctl = (gu32*)(args.ws + WS_CTL);
    for (int u = F.tid; u < (LDS_BYTES - LDSCTL_OFF) / 4; u += NTHREADS) ((LAS unsigned*)(F.lds + LDSCTL_OFF))[u] = 0u;
    __syncthreads();
    XcdBarrier bar; bar.bar = (unsigned*)(F.ctl + CW_BAR); bar.x = 0; bar.st = nullptr;
    if (!MK_SPLIT) bar = xcd_barrier_post((unsigned*)(F.ctl + CW_BAR), F.MISC + 8);
    const int lo = args.ph_lo, hi = args.ph_hi;
#ifndef PH_MASK
#define PH_MASK 0xffff
#endif
#define IN(k) (((PH_MASK >> (k)) & 1) && lo <= (k) && (k) < hi)
#define SEAM(k) do { if (IN(k) && IN((k) + 1)) xcd_barrier(bar); } while (0)

    if (IN(0)) { p0_prologue(args, F); } SEAM(0);
    if (IN(1)) { p1_hprep(args, F); } SEAM(1);
    if (IN(2)) {
        pg8::Gemm g{(const pg8::bf16_t*)(args.ws + WS_HN), (const pg8::bf16_t*)(args.ws + WS_WIN), M, NREG, 1024, 1024, 0};
        pg8::StaticOrder S; S.init(M, NREG, F.G, (int)blockIdx.x);
        EpiG1 E{args.ws, args.out};
        pg8::gemm_phase<EpiG1, pg8::StaticOrder, true, true>(F.lds, g, S, E);
    } SEAM(2);
    if (IN(3)) {
        for (int it = F.vcu; it < M / 64; it += F.G) conv_item(args, F, it);
        LAS float* pscr = (LAS float*)(F.lds + F.wave * 1024);
        const int gw = F.vcu * NWAVES + F.wave, NGW = F.G * NWAVES;
        for (int task = gw; task < MS * 24; task += NGW) { const int row = MP + task / 24, gh = task % 24; attn_valu_task(args, F, row, gh >> 3, gh & 7, pscr); }
        for (int au = F.vcu; au < NBP * 3 * 8 * 32; au += F.G) attn_mfma_unit(args, F, au);
        __syncthreads();
    } SEAM(3);
    if (IN(4)) {
        pg8::Gemm g{(const pg8::bf16_t*)(args.ws + WS_CACT), (const pg8::bf16_t*)(args.ws + WS_WQK), M, 1024, 256, 1024, 256};
        pg8::StaticOrder S; S.init(M, 1024, F.G, (int)blockIdx.x);
        EpiMQK E{args.ws};
        pg8::gemm_phase<EpiMQK, pg8::StaticOrder, true, true>(F.lds, g, S, E);
        combine_rows(args, F);
    } SEAM(4);
    if (IN(5)) {
        for (int it = F.vcu; it < NUNIT + DBS * 4; it += F.G) {
            if (it < NUNIT) ml_dc_unit(args, F, it);
            else { const int u = it - NUNIT, b = u >> 2, hd = u & 3;
                mlstm_recurrent_unit(args, F, MP + b * 8, 8, hd, args.in[I_SC] + (size_t)u * 32768, args.in[I_SN] + (size_t)u * 128, args.in[I_SM] + u,
                                     args.out + O_CSTS + (size_t)u * 32768, args.out + O_NS + (size_t)u * 128, args.out + O_MS + u); }
        }
    } SEAM(5);
    if (IN(6)) ml_cscan(args, F);
    SEAM(6);
    if (IN(7)) { for (int it = F.vcu; it < NUNIT; it += F.G) ml_out_unit(args, F, it); __syncthreads(); }
    SEAM(7);
    if (IN(8)) {
        { pg8::Gemm g{(const pg8::bf16_t*)(args.ws + WS_A3), (const pg8::bf16_t*)(args.ws + WS_WPA), M, 1024, 512, 512, 0};
          pg8::StaticOrder S; S.init(M, 1024, F.G, (int)blockIdx.x); EpiBranch<0> E{args.ws};
          pg8::gemm_phase<EpiBranch<0>, pg8::StaticOrder, true, true>(F.lds, g, S, E); }
        VM_WAIT(); __syncthreads();
        { pg8::Gemm g{(const pg8::bf16_t*)(args.ws + WS_A4), (const pg8::bf16_t*)(args.ws + WS_WPM), M, 1024, 1024, 1024, 0};
          pg8::StaticOrder S; S.init(M, 1024, F.G, (int)blockIdx.x); EpiBranch<1> E{args.ws};
          pg8::gemm_phase<EpiBranch<1>, pg8::StaticOrder, true, true>(F.lds, g, S, E); }
    } SEAM(8);
    if (IN(9)) {
        pg8::Gemm g{(const pg8::bf16_t*)(args.ws + WS_MRG), (const pg8::bf16_t*)(args.ws + WS_WOUT), M, 1024, 1024, 1024, 0};
        pg8::StaticOrder S; S.init(M, 1024, F.G, (int)blockIdx.x); EpiOut E{args.ws, args.out, args.in[I_XP], args.in[I_XS]};
        pg8::gemm_phase<EpiOut, pg8::StaticOrder, true, true>(F.lds, g, S, E);
    } SEAM(9);
    if (IN(10)) final_norm(args, F);
#undef IN
#undef SEAM
}

extern "C" void kernel_launch(void* const* d_in, const int* in_sizes, int n_in, void* d_out, int out_size, void* d_ws, size_t ws_size, hipStream_t stream) {
    static int grid = 0;
    if (grid == 0) {
        if (n_in != N_IN || (size_t)out_size != O_END || ws_size < WS_END) { fprintf(stderr, "kernel_launch: unexpected shapes: n_in %d out %d ws %zu (need %zu)\n", n_in, out_size, ws_size, (size_t)WS_END); grid = -1; return; }
        int dev = 0, cus = 0, per_cu = 0;
        if (hipGetDevice(&dev) != hipSuccess || hipDeviceGetAttribute(&cus, hipDeviceAttributeMultiprocessorCount, dev) != hipSuccess) { grid = -1; return; }
        if (hipFuncSetAttribute((const void*)mk_fwd, hipFuncAttributeMaxDynamicSharedMemorySize, LDS_BYTES) != hipSuccess) { fprintf(stderr, "kernel_launch: hipFuncSetAttribute failed\n"); grid = -1; return; }
        if (hipOccupancyMaxActiveBlocksPerMultiprocessor(&per_cu, (const void*)mk_fwd, NTHREADS, LDS_BYTES) != hipSuccess || per_cu < 1) { fprintf(stderr, "kernel_launch: occupancy query says %d blocks per CU\n", per_cu); (void)hipGetLastError(); grid = -1; return; }
        grid = cus;
    }
    if (grid < 0) return;
    if (hipMemsetAsync((char*)d_ws + WS_CTL, 0, CTL_ZERO_BYTES, stream) != hipSuccess) return;
    Args a{};
    for (int i = 0; i < N_IN; ++i) a.in[i] = (const float*)d_in[i];
    a.out = (float*)d_out; a.ws = (unsigned char*)d_ws;
#if MK_SPLIT
    for (int p = 0; p < N_PHASES; ++p) { a.ph_lo = p; a.ph_hi = p + 1; hipLaunchKernelGGL(mk_fwd, dim3(grid), dim3(NTHREADS), LDS_BYTES, stream, a); }
#else
    a.ph_lo = 0; a.ph_hi = N_PHASES;
    void* kargs[] = {&a};
    hipError_t e = hipLaunchCooperativeKernel((const void*)mk_fwd, dim3(grid), dim3(NTHREADS), kargs, LDS_BYTES, stream);
    if (e != hipSuccess) fprintf(stderr, "kernel_launch: cooperative launch failed: %s (grid %d)\n", hipGetErrorString(e), grid);
#endif
}
```

```cpp
#include <hip/hip_runtime.h>
#include <cstdio>
#include <cstdint>
namespace pg8 {
#define PG8_LAS __attribute__((address_space(3)))
typedef unsigned short bf16_t;
typedef short bf16x8 __attribute__((ext_vector_type(8)));
typedef float f32x4 __attribute__((ext_vector_type(4)));
typedef unsigned u32x4 __attribute__((ext_vector_type(4)));
constexpr int BM = 256, BK = 64, HALF = 128, HTB = HALF * BK * 2  , STAGE_BYTES = 8 * HTB, NXCD = 8, WGM = 8;

__host__ __device__ __forceinline__ int lds_byte(int r, int c) { const int st = (r >> 4) * 2 + (c >> 5), rr = r & 15, cc = c & 31, ob = rr * 64 + cc * 2; return st * 1024 + (ob ^ (((ob >> 9) & 1) << 5)); }
__host__ __device__ __forceinline__ void stage_rc(int b, int& R, int& C) { const int st = b / 1024, sb = b % 1024, swz = sb ^ (((sb >> 9) & 1) << 5); R = (st >> 1) * 16 + swz / 64; C = (st & 1) * 32 + (swz % 64) / 2; }
__host__ __device__ __forceinline__ int perm32(int rho) { const int n = rho >> 4, i = rho & 15; return 8 * (i >> 2) + 4 * n + (i & 3); }

struct Unit { int pm, pn; };
struct Gemm { const bf16_t* A; const bf16_t* Bt; int M, N, K, lda, a_pn_off; };

struct StaticOrder {
    int nM, nN, nwg, G, c;
    __host__ __device__ void init(int M, int N, int G_, int c_) { nM = M / BM; nN = N / BM; nwg = nM * nN; G = G_; c = c_; }
    __host__ __device__ bool next(int i, Unit& u) const {
        const long L = (long)i * G + c; if (L >= nwg) return false;
        int wgid = (int)L; { const int q = nwg / NXCD, r = nwg % NXCD, xcd = wgid % NXCD, off = wgid / NXCD; wgid = (xcd < r ? xcd * (q + 1) : r * (q + 1) + (xcd - r) * q) + off; }
        const int nig = WGM * nN, gid = wgid / nig, fm = gid * WGM, gsz = (nM - fm) < WGM ? (nM - fm) : WGM;
        u.pm = fm + ((wgid % nig) % gsz); u.pn = (wgid % nig) / gsz; return true;
    }
    __device__ __forceinline__ void a_ready(const Unit&) const {}
    __device__ __forceinline__ void done(const Unit&) const {}
};

typedef float cvt_f32x2_t __attribute__((ext_vector_type(2))); typedef __bf16 cvt_bf16x2_t __attribute__((ext_vector_type(2)));
__device__ __forceinline__ unsigned cvt_pk_bf16(float lo, float hi) { cvt_f32x2_t v = {lo, hi}; cvt_bf16x2_t b = __builtin_convertvector(v, cvt_bf16x2_t); return __builtin_bit_cast(unsigned, b); }
template <class Epi, class Sched, bool ALIGN_EPI = false, bool SP2 = false>
__device__ __forceinline__ void gemm_phase(PG8_LAS unsigned char* lds, const Gemm g, const Sched& S, const Epi& E) {
    const int tid = threadIdx.x, wid = __builtin_amdgcn_readfirstlane(tid >> 6), lane = tid & 63, wr = wid >> 2, wc = wid & 3, fr = lane & 15, fq = lane >> 4;
    const int K = g.K, nt = K / BK;
    unsigned voffA[2], voffB[2];
#pragma unroll
    for (int i = 0; i < 2; ++i) { int R, C; stage_rc(tid * 16 + i * 8192, R, C); const int Rb = Epi::PERM ? ((R & ~31) + perm32(R & 31)) : R;
        voffA[i] = (unsigned)(R * g.lda + C) * 2u; voffB[i] = (unsigned)(Rb * K + C) * 2u; }
    const size_t kstep = (size_t)(BK * 2);
    const size_t hstepA = (size_t)HALF * g.lda * 2, hstepB = (size_t)HALF * K * 2;
    const size_t tstepA = 2 * hstepA, tstepB = 2 * hstepB;
    const size_t apn = (size_t)g.a_pn_off * 2;
    const unsigned ldsw = (unsigned)wid * 1024u;
    const int aoff = lds_byte(wr * 64 + fr, fq * 8), boff = lds_byte(wc * 32 + fr, fq * 8);
#define PG8_SA(b, h) (((b) * 2 + (h)) * HTB)
#define PG8_SB(b, h) ((4 + (b) * 2 + (h)) * HTB)
#define PG8_STAGE(bufoff, gbase, voff) do { _Pragma("unroll") for (int _i = 0; _i < 2; ++_i) \
        __builtin_amdgcn_global_load_lds((const unsigned*)((const char*)(gbase) + (voff)[_i]), (PG8_LAS unsigned*)(lds + (bufoff) + ldsw + _i * 8192), 16, 0, 0); } while (0)
#define PG8_LDA(dst, b, h) do { _Pragma("unroll") for (int m = 0; m < 4; ++m) _Pragma("unroll") for (int k = 0; k < 2; ++k) dst[m][k] = *(const PG8_LAS bf16x8*)(lds + PG8_SA(b, h) + aoff + m * 2048 + k * 1024); } while (0)
#define PG8_LDB(dst, b, h) do { _Pragma("unroll") for (int n = 0; n < 2; ++n) _Pragma("unroll") for (int k = 0; k < 2; ++k) dst[n][k] = *(const PG8_LAS bf16x8*)(lds + PG8_SB(b, h) + boff + n * 2048 + k * 1024); } while (0)
#define PG8_MMA(ai, bj, At, Bt) do { __builtin_amdgcn_s_setprio(1); _Pragma("unroll") for (int m = 0; m < 4; ++m) _Pragma("unroll") for (int n = 0; n < 2; ++n) _Pragma("unroll") for (int k = 0; k < 2; ++k) \
        acc[ai][bj][m][n] = __builtin_amdgcn_mfma_f32_16x16x32_bf16(Bt[n][k], At[m][k], acc[ai][bj][m][n], 0, 0, 0); __builtin_amdgcn_s_setprio(0); } while (0)
#define PG8_WAIT_V(n) asm volatile("s_waitcnt vmcnt(" #n ")" ::: "memory")
#define PG8_WAIT_L(n) asm volatile("s_waitcnt lgkmcnt(" #n ")" ::: "memory")
#define PG8_BAR __builtin_amdgcn_s_barrier()
#define PG8_SCHED __builtin_amdgcn_sched_barrier(0)
    Unit cur, nxt; int ui = 0;
    if (!S.next(0, cur)) return;
    f32x4 acc[2][2][4][2];
#pragma unroll
    for (int a = 0; a < 2; ++a)
#pragma unroll
        for (int b = 0; b < 2; ++b)
#pragma unroll
            for (int m = 0; m < 4; ++m)
#pragma unroll
                for (int n = 0; n < 2; ++n) acc[a][b][m][n] = (f32x4){0.f, 0.f, 0.f, 0.f};
    bf16x8 At[4][2], B0[2][2], B1[2][2];
    const char* cA = (const char*)g.A + (size_t)cur.pm * tstepA + (size_t)cur.pn * apn; const char* cB = (const char*)g.Bt + (size_t)cur.pn * tstepB;
    S.a_ready(cur);
    if constexpr (SP2) {
        PG8_STAGE(PG8_SB(0, 0), cB, voffB); PG8_STAGE(PG8_SB(0, 1), cB + hstepB, voffB); PG8_STAGE(PG8_SA(0, 0), cA, voffA); PG8_STAGE(PG8_SA(0, 1), cA + hstepA, voffA);
        if (wr == 1) PG8_BAR;
        PG8_WAIT_V(2); PG8_BAR;
        PG8_STAGE(PG8_SB(1, 0), cB + kstep, voffB); PG8_STAGE(PG8_SA(1, 0), cA + kstep, voffA); PG8_STAGE(PG8_SB(1, 1), cB + hstepB + kstep, voffB);
        PG8_WAIT_V(6); PG8_BAR;
    } else {
        PG8_STAGE(PG8_SB(0, 0), cB, voffB); PG8_STAGE(PG8_SA(0, 0), cA, voffA); PG8_STAGE(PG8_SB(0, 1), cB + hstepB, voffB); PG8_STAGE(PG8_SA(0, 1), cA + hstepA, voffA);
        if (wr == 1) PG8_BAR;
        PG8_WAIT_V(4); PG8_BAR;
        PG8_STAGE(PG8_SB(1, 0), cB + kstep, voffB); PG8_STAGE(PG8_SA(1, 0), cA + kstep, voffA); PG8_STAGE(PG8_SB(1, 1), cB + hstepB + kstep, voffB);
        PG8_WAIT_V(6); PG8_BAR;
    }
    for (;;) {
        const bool has_next = S.next(ui + 1, nxt);
        const char* nA = has_next ? (const char*)g.A + (size_t)nxt.pm * tstepA + (size_t)nxt.pn * apn : cA; const char* nB = has_next ? (const char*)g.Bt + (size_t)nxt.pn * tstepB : cB;
#pragma nounroll
        for (int t = 0; t < nt; t += 2) {
            const bool last = (t == nt - 2);
            const char* a1 = cA + (size_t)(t + 1) * kstep;
            const char* a2 = last ? nA : cA + (size_t)(t + 2) * kstep; const char* b2 = last ? nB : cB + (size_t)(t + 2) * kstep;
            const char* a3 = a2 + kstep; const char* b3 = b2 + kstep;
            if (last && has_next) S.a_ready(nxt);
            if constexpr (SP2) {
            PG8_LDB(B0, 0, 0); PG8_LDB(B1, 0, 1); PG8_SCHED; PG8_LDA(At, 0, 0); PG8_STAGE(PG8_SA(1, 1), a1 + hstepA, voffA);
            PG8_WAIT_V(8); PG8_WAIT_L(0); PG8_BAR; PG8_MMA(0, 0, At, B0); PG8_MMA(0, 1, At, B1); PG8_BAR; PG8_SCHED;
            PG8_LDA(At, 0, 1); PG8_STAGE(PG8_SB(0, 0), b2, voffB); PG8_STAGE(PG8_SB(0, 1), b2 + hstepB, voffB); PG8_STAGE(PG8_SA(0, 0), a2, voffA);
            PG8_WAIT_V(8); PG8_WAIT_L(0); PG8_BAR; PG8_MMA(1, 0, At, B0); PG8_MMA(1, 1, At, B1); PG8_BAR; PG8_SCHED;
            PG8_LDB(B0, 1, 0); PG8_LDB(B1, 1, 1); PG8_SCHED; PG8_LDA(At, 1, 0); PG8_STAGE(PG8_SA(0, 1), a2 + hstepA, voffA);
            PG8_WAIT_V(8); PG8_WAIT_L(0); PG8_BAR; PG8_MMA(0, 0, At, B0); PG8_MMA(0, 1, At, B1); PG8_BAR; PG8_SCHED;
            PG8_LDA(At, 1, 1); PG8_STAGE(PG8_SB(1, 0), b3, voffB); PG8_STAGE(PG8_SB(1, 1), b3 + hstepB, voffB); PG8_STAGE(PG8_SA(1, 0), a3, voffA);
            PG8_WAIT_V(8); PG8_WAIT_L(0); PG8_BAR; PG8_MMA(1, 0, At, B0); PG8_MMA(1, 1, At, B1); PG8_BAR; PG8_SCHED;
            } else {
            PG8_LDB(B0, 0, 0); PG8_SCHED; PG8_LDA(At, 0, 0); PG8_STAGE(PG8_SA(1, 1), a1 + hstepA, voffA);
            PG8_WAIT_L(8); PG8_BAR; PG8_WAIT_L(0); PG8_MMA(0, 0, At, B0); PG8_BAR; PG8_SCHED;
            PG8_LDB(B1, 0, 1); PG8_STAGE(PG8_SB(0, 0), b2, voffB);
            PG8_BAR; PG8_WAIT_L(0); PG8_MMA(0, 1, At, B1); PG8_BAR;
            PG8_LDA(At, 0, 1); PG8_STAGE(PG8_SA(0, 0), a2, voffA);
            PG8_BAR; PG8_WAIT_L(0); PG8_MMA(1, 0, At, B0); PG8_BAR; PG8_SCHED;
            PG8_STAGE(PG8_SB(0, 1), b2 + hstepB, voffB);
            PG8_WAIT_V(6); PG8_BAR; PG8_MMA(1, 1, At, B1); PG8_BAR;
            PG8_LDB(B0, 1, 0); PG8_SCHED; PG8_LDA(At, 1, 0); PG8_STAGE(PG8_SA(0, 1), a2 + hstepA, voffA);
            PG8_WAIT_L(8); PG8_BAR; PG8_WAIT_L(0); PG8_MMA(0, 0, At, B0); PG8_BAR; PG8_SCHED;
            PG8_LDB(B1, 1, 1); PG8_STAGE(PG8_SB(1, 0), b3, voffB);
            PG8_BAR; PG8_WAIT_L(0); PG8_MMA(0, 1, At, B1); PG8_BAR;
            PG8_LDA(At, 1, 1); PG8_STAGE(PG8_SA(1, 0), a3, voffA);
            PG8_BAR; PG8_WAIT_L(0); PG8_MMA(1, 0, At, B0); PG8_BAR; PG8_SCHED;
            PG8_STAGE(PG8_SB(1, 1), b3 + hstepB, voffB);
            PG8_WAIT_V(6); PG8_BAR; PG8_MMA(1, 1, At, B1); PG8_BAR;
            }
        }
        if constexpr (ALIGN_EPI) { if (wr == 0) PG8_BAR; }
        if constexpr (!Epi::AFTER_DRAIN) { E(acc, cur, wr, wc, fr, fq); S.done(cur); }
        if (!has_next) break;
#pragma unroll
        for (int a = 0; a < 2; ++a)
#pragma unroll
            for (int b = 0; b < 2; ++b)
#pragma unroll
                for (int m = 0; m < 4; ++m)
#pragma unroll
                    for (int n = 0; n < 2; ++n) acc[a][b][m][n] = (f32x4){0.f, 0.f, 0.f, 0.f};
        cur = nxt; cA = nA; cB = nB; ++ui;
        if constexpr (ALIGN_EPI) { if (wr == 1) PG8_BAR; }
    }
    PG8_WAIT_V(0);
    if constexpr (!ALIGN_EPI) { if (wr == 0) PG8_BAR; }
    PG8_BAR;
    if constexpr (Epi::AFTER_DRAIN) { E.fused(acc, cur, wr, wc, fr, fq, lds, wid, lane); S.done(cur); }
#undef PG8_SA
#undef PG8_SB
#undef PG8_STAGE
#undef PG8_LDA
#undef PG8_LDB
#undef PG8_MMA
#undef PG8_WAIT_V
#undef PG8_WAIT_L
#undef PG8_BAR
#undef PG8_SCHED
}
}

constexpr int DMODEL = 1024;
constexpr int NBP = 2, SEQ = 8192, MP = NBP * SEQ;
constexpr int DBS = 32, TS = 8, MS = DBS * TS;
constexpr int M = MP + MS;
constexpr int PROJ_W = 10248, NREG = 10240;
constexpr int NBATCH = NBP + DBS;
constexpr float EPS = 1e-6f;
enum { I_XP = 0, I_XS, I_KV128, I_KV512, I_KV2048, I_SCONV, I_SC, I_SN, I_SM, I_CP, I_CS, I_REL, I_NG, I_WADA, I_BADA, I_WIN, I_BIF,
       I_CONVW, I_CONVB, I_WMQ, I_WMK, I_MNORM, I_MSKIP, I_WPA, I_WPM, I_WOUT, I_FG, N_IN };
constexpr size_t O_YP = 0;
constexpr size_t O_YS = O_YP + (size_t)MP * 1024;
constexpr size_t O_KV128P = O_YS + (size_t)MS * 1024;
constexpr size_t O_KV128S = O_KV128P + (size_t)NBP * 128 * 1024;
constexpr size_t O_KV512P = O_KV128S + (size_t)DBS * 128 * 1024;
constexpr size_t O_KV512S = O_KV512P + (size_t)NBP * 512 * 1024;
constexpr size_t O_KV2048P = O_KV512S + (size_t)DBS * 512 * 1024;
constexpr size_t O_KV2048S = O_KV2048P + (size_t)NBP * 2048 * 1024;
constexpr size_t O_CONVP = O_KV2048S + (size_t)DBS * 2048 * 1024;
constexpr size_t O_CONVS = O_CONVP + (size_t)NBP * 3 * 1024;
constexpr size_t O_CSTP = O_CONVS + (size_t)DBS * 3 * 1024;
constexpr size_t O_CSTS = O_CSTP + (size_t)NBP * 4 * 256 * 128;
constexpr size_t O_NP = O_CSTS + (size_t)DBS * 4 * 256 * 128;
constexpr size_t O_NS = O_NP + (size_t)NBP * 4 * 128;
constexpr size_t O_MP = O_NS + (size_t)DBS * 4 * 128;
constexpr size_t O_MS = O_MP + (size_t)NBP * 4;
constexpr size_t O_END = O_MS + (size_t)DBS * 4;

constexpr size_t wsal(size_t x) { return (x + 65535) & ~(size_t)65535; }
constexpr size_t WS_CTL = 0, CTL_ZERO_BYTES = 1u << 20;
constexpr size_t WS_WIN = wsal(WS_CTL + CTL_ZERO_BYTES);
constexpr size_t WS_WQK = wsal(WS_WIN + (size_t)NREG * 1024 * 2);
constexpr size_t WS_WPA = wsal(WS_WQK + (size_t)1024 * 256 * 2);
constexpr size_t WS_WPM = wsal(WS_WPA + (size_t)1024 * 512 * 2);
constexpr size_t WS_WOUT = wsal(WS_WPM + (size_t)1024 * 1024 * 2);
constexpr size_t WS_ADAP = wsal(WS_WOUT + (size_t)1024 * 1024 * 2);
constexpr size_t WS_GATE = wsal(WS_ADAP + (size_t)4 * NBATCH * 3072 * 4);
constexpr size_t WS_GATES = wsal(WS_GATE + (size_t)NBATCH * 1024 * 4);
constexpr size_t WS_HN = wsal(WS_GATES + (size_t)M * 8 * 4);
constexpr size_t WS_QKV = wsal(WS_HN + (size_t)M * 1024 * 2);
constexpr size_t WS_ZA = wsal(WS_QKV + (size_t)M * 4608 * 2);
constexpr size_t WS_XM = wsal(WS_ZA + (size_t)M * 512 * 2);
constexpr size_t WS_ZM = wsal(WS_XM + (size_t)M * 1024 * 2);
constexpr size_t WS_OM = wsal(WS_ZM + (size_t)M * 1024 * 2);
constexpr size_t WS_GA = wsal(WS_OM + (size_t)M * 1024 * 2);
constexpr size_t WS_GM = wsal(WS_GA + (size_t)M * 1024 * 2);
constexpr size_t WS_CACT = wsal(WS_GM + (size_t)M * 1024 * 2);
constexpr size_t WS_QM = wsal(WS_CACT + (size_t)M * 1024 * 2);
constexpr size_t WS_KM = wsal(WS_QM + (size_t)M * 512 * 2);
constexpr size_t WS_OG = wsal(WS_KM + (size_t)M * 512 * 2);
constexpr size_t WS_LSE = wsal(WS_OG + (size_t)M * 1536 * 2);
constexpr size_t WS_A3 = wsal(WS_LSE + (size_t)M * 24 * 4);
constexpr size_t WS_A4 = wsal(WS_A3 + (size_t)M * 512 * 2);
constexpr size_t WS_PA = wsal(WS_A4 + (size_t)M * 1024 * 2);
constexpr size_t WS_MRG = wsal(WS_PA + (size_t)M * 1024 * 2);
constexpr int NCH = 64, LCH = 128, NUNIT = NBP * 4 * NCH;
constexpr size_t WS_DCP = wsal(WS_MRG + (size_t)M * 1024 * 2);
constexpr size_t WS_DNP = wsal(WS_DCP + (size_t)NUNIT * 32768 * 2);
constexpr size_t WS_CHST = wsal(WS_DNP + (size_t)NUNIT * 128 * 4);
constexpr size_t WS_CPREV = wsal(WS_CHST + (size_t)NUNIT * 2 * 4);
constexpr size_t WS_NPREV = wsal(WS_CPREV + (size_t)NUNIT * 32768 * 2);
constexpr size_t WS_MPREV = wsal(WS_NPREV + (size_t)NUNIT * 128 * 4);
constexpr size_t WS_SSQ = wsal(WS_MPREV + (size_t)NUNIT * 4);
constexpr size_t WS_END = wsal(WS_SSQ + (size_t)M * 16 * 4);
constexpr int CW_BAR = 4096;

constexpr int RING_BYTES = 131072, LDSCTL_OFF = RING_BYTES, MISC_OFF = LDSCTL_OFF + 320, LDS_BYTES = 147456;
constexpr int NWAVES = 8, NTHREADS = 512;

#define GAS __attribute__((address_space(1)))
#define LAS __attribute__((address_space(3)))
typedef unsigned short bf16;
typedef unsigned v4u __attribute__((ext_vector_type(4)));
typedef unsigned v2u __attribute__((ext_vector_type(2)));
typedef float f32x4 __attribute__((ext_vector_type(4)));
typedef float f32x16 __attribute__((ext_vector_type(16)));
typedef short bf16x8 __attribute__((ext_vector_type(8)));
typedef short s16x4 __attribute__((ext_vector_type(4)));
typedef GAS unsigned gu32;
#define RLX_AGENT __ATOMIC_RELAXED, __HIP_MEMORY_SCOPE_AGENT
#define LDS_WAIT() asm volatile("s_waitcnt lgkmcnt(0)" ::: "memory")
#define VM_WAIT() asm volatile("s_waitcnt vmcnt(0)" ::: "memory")
__device__ __forceinline__ unsigned f2bf(float f) { unsigned u = __builtin_bit_cast(unsigned, f); return (u + 0x7fffu + ((u >> 16) & 1u)) >> 16; }
__device__ __forceinline__ unsigned pk2(float lo, float hi) { return f2bf(lo) | (f2bf(hi) << 16); }
__device__ __forceinline__ float bflo(unsigned w) { return __builtin_bit_cast(float, w << 16); }
__device__ __forceinline__ float bfhi(unsigned w) { return __builtin_bit_cast(float, w & 0xffff0000u); }
__device__ __forceinline__ float bf1(bf16 h) { return __builtin_bit_cast(float, (unsigned)h << 16); }
__device__ __forceinline__ float fast_rcp(float x) { return __builtin_amdgcn_rcpf(x); }
__device__ __forceinline__ float sigmoidf_(float x) { return fast_rcp(1.f + __expf(-x)); }
__device__ __forceinline__ float siluf_(float x) { return x * sigmoidf_(x); }
__device__ __forceinline__ float logsigmoidf_(float x) { return fminf(x, 0.f) - log1pf(__expf(-fabsf(x))); }
__device__ __forceinline__ float wave_sum(float v) {
#pragma unroll
    for (int o = 1; o < 64; o <<= 1) v += __shfl_xor(v, o);
    return v;
}
__device__ __forceinline__ float wave_max(float v) {
#pragma unroll
    for (int o = 1; o < 64; o <<= 1) v = fmaxf(v, __shfl_xor(v, o));
    return v;
}
#define XB_TMO      128
#define XB_XCNT(j)  (256  + 64 * (j))
#define XB_XSUB(j)  (1280 + 64 * (j))
#define XB_XGEN(j)  (2304 + 64 * (j))
#define XB_TOP      3328
#define XB_TOPGEN   3392
#define XCD_BAR_WORDS 3456
#define XB_SPIN_CAP (1u << 18)

__device__ __forceinline__ unsigned xb_ld(unsigned* p)              { return __hip_atomic_load(p, __ATOMIC_RELAXED, __HIP_MEMORY_SCOPE_AGENT); }
__device__ __forceinline__ unsigned xb_add(unsigned* p, unsigned v) { return __hip_atomic_fetch_add(p, v, __ATOMIC_RELAXED, __HIP_MEMORY_SCOPE_AGENT); }
__device__ __forceinline__ unsigned xb_xcc_id() { return (unsigned)__builtin_amdgcn_s_getreg((3 << 11) | 20) & 0xFu; }
#define XB_SPIN(cond, bar) do { unsigned _sp = 0; while (cond) { __builtin_amdgcn_s_sleep(1); \
    if ((++_sp & 255u) == 0u) { if (xb_ld(&(bar)[XB_TMO])) break; if (_sp > XB_SPIN_CAP) { atomicAdd(&(bar)[XB_TMO], 1u); break; } } } } while (0)

struct XcdBarrier {
    unsigned* bar; unsigned x;
    volatile LAS unsigned* st;
};

__device__ __forceinline__ XcdBarrier xcd_barrier_post(unsigned* bar, volatile LAS unsigned* st) {
    XcdBarrier b; b.bar = bar; b.x = xb_xcc_id(); b.st = st;
    if (threadIdx.x == 0) (void)xb_add(&bar[XB_XCNT(b.x)], 1u);
    return b;
}
__device__ __forceinline__ void xcd_barrier_complete(unsigned* bar, unsigned x, unsigned& nloc, unsigned& nx) {
    const unsigned G = gridDim.x * gridDim.y * gridDim.z;
    unsigned sum, cnt, mine, sp = 0u;
    for (;;) {
        sum = 0u; cnt = 0u; mine = 0u;
#pragma unroll
        for (unsigned j = 0; j < 16; ++j) { const unsigned c = xb_ld(&bar[XB_XCNT(j)]); sum += c; cnt += (c > 0u) ? 1u : 0u; mine = (j == x) ? c : mine; }
        if (sum == G) break;
        __builtin_amdgcn_s_sleep(1);
        if ((++sp & 255u) == 0u) { if (xb_ld(&bar[XB_TMO])) break; if (sp > XB_SPIN_CAP) { atomicAdd(&bar[XB_TMO], 1u); break; } }
    }
    nloc = mine > 0u ? mine : 1u; nx = cnt > 0u ? cnt : 1u;
}

__device__ __forceinline__ void xcd_barrier(const XcdBarrier& b) {
    asm volatile("s_waitcnt vmcnt(0)" ::: "memory");
    __syncthreads();
    if (threadIdx.x == 0) {
        unsigned* bar = b.bar;
        __builtin_amdgcn_s_waitcnt(0);
        unsigned nloc = b.st[0], nx = b.st[1];
        if (nloc == 0u) { xcd_barrier_complete(bar, b.x, nloc, nx); b.st[0] = nloc; b.st[1] = nx; }
        const unsigned old = xb_add(&bar[XB_XSUB(b.x)], 1u);
        const unsigned gen = old / nloc;
        if (old + 1u == (gen + 1u) * nloc) {
            __builtin_amdgcn_fence(__ATOMIC_RELEASE, "agent");
            asm volatile("s_waitcnt vmcnt(0)" ::: "memory");
            const unsigned og = xb_add(&bar[XB_TOP], 1u);
            const unsigned tg = og / nx;
            if (og + 1u == (tg + 1u) * nx) xb_add(&bar[XB_TOPGEN], 1u);
            else XB_SPIN(xb_ld(&bar[XB_TOPGEN]) == tg, bar);
            __builtin_amdgcn_fence(__ATOMIC_ACQUIRE, "agent");
            xb_add(&bar[XB_XGEN(b.x)], 1u);
            asm volatile("s_waitcnt vmcnt(0)" ::: "memory");
        } else {
            XB_SPIN(xb_ld(&bar[XB_XGEN(b.x)]) == gen, bar);
            __builtin_amdgcn_fence(__ATOMIC_ACQUIRE, "agent");
            asm volatile("s_waitcnt vmcnt(0)" ::: "memory");
        }
    }
    __syncthreads();
}

struct Args { const float* in[N_IN]; float* out; unsigned char* ws; int ph_lo, ph_hi; };
struct Frame {
    LAS unsigned char* lds;
    volatile LAS unsigned* MISC;
    gu32* ctl;
    int tid, lane, wave, vcu, G;
};

__device__ __forceinline__ void transpose_item(const float* W, int ldw, int c0, int k0, bf16* WT, int ldt, int r0, float s, LAS float* scr, int lane) {
#pragma unroll 8
    for (int i = 0; i < 32; ++i) { const int kk = 2 * i + (lane >> 5); scr[kk * 33 + (lane & 31)] = W[(size_t)(k0 + kk) * ldw + c0 + (lane & 31)]; }
    LDS_WAIT(); asm volatile("" ::: "memory");
    const int c = lane & 7;
#pragma unroll
    for (int j = 0; j < 4; ++j) { const int n = (lane >> 3) + 8 * j; const LAS float* p = scr + (8 * c) * 33 + n;
        v4u o; o.x = pk2(p[0 * 33] * s, p[1 * 33] * s); o.y = pk2(p[2 * 33] * s, p[3 * 33] * s); o.z = pk2(p[4 * 33] * s, p[5 * 33] * s); o.w = pk2(p[6 * 33] * s, p[7 * 33] * s);
        *(GAS v4u*)(WT + (size_t)(r0 + n) * ldt + k0 + 8 * c) = o; }
    LDS_WAIT(); asm volatile("" ::: "memory");
}
__device__ __forceinline__ void ada_item(const Args& a, Frame& F, int item) {
    const int nt = item % 48, ks = item / 48, n0 = nt * 64, k0 = ks * 256;
    LAS float* sc = (LAS float*)F.lds;
    LAS float* red = sc + 34 * 256;
    for (int i = F.tid; i < 34 * 256; i += NTHREADS) { const int b = i >> 8, k = i & 255;
        const float c = (b < 2) ? a.in[I_CP][b * 1024 + k0 + k] : a.in[I_CS][(b - 2) * 1024 + k0 + k];
        sc[i] = siluf_(c); }
    __syncthreads();
    const int cl = F.tid & 63, kg = F.tid >> 6;
    float acc[34];
#pragma unroll
    for (int b = 0; b < 34; ++b) acc[b] = 0.f;
    const float* w = a.in[I_WADA] + (size_t)(k0 + kg * 32) * 3072 + n0 + cl;
    for (int kk = 0; kk < 32; kk += 4) {
        const float w0 = w[(size_t)(kk + 0) * 3072], w1 = w[(size_t)(kk + 1) * 3072], w2 = w[(size_t)(kk + 2) * 3072], w3 = w[(size_t)(kk + 3) * 3072];
#pragma unroll
        for (int b = 0; b < 34; ++b) { const f32x4 s = *(const LAS f32x4*)(sc + b * 256 + kg * 32 + kk); acc[b] += s.x * w0 + s.y * w1 + s.z * w2 + s.w * w3; }
    }
#pragma unroll
    for (int b = 0; b < 34; ++b) red[(kg * 34 + b) * 64 + cl] = acc[b];
    __syncthreads();
    float* adap = (float*)(a.ws + WS_ADAP);
    for (int i = F.tid; i < 34 * 64; i += NTHREADS) { const int b = i >> 6, c = i & 63; float s = 0.f;
#pragma unroll
        for (int g = 0; g < 8; ++g) s += red[(g * 34 + b) * 64 + c];
        adap[(size_t)(ks * 34 + b) * 3072 + n0 + c] = s; }
    __syncthreads();
}
constexpr int CP_ROWS0 = DBS * 120, CP_ROWS1 = DBS * 504, CP_ROWS2 = DBS * 2040, CP_ROWS = CP_ROWS0 + CP_ROWS1 + CP_ROWS2;
__device__ __forceinline__ void p0_prologue(const Args& a, Frame& F) {
    if (F.vcu < 192) ada_item(a, F, F.vcu);
    LAS float* scr = (LAS float*)(F.lds + F.wave * 16384);
    const int gw = F.vcu * NWAVES + F.wave, NGW = F.G * NWAVES;
    constexpr int I_IN = 16 * 320, I_QK = 128, I_PA = 8 * 32, I_PM = 16 * 32, I_OUT = 16 * 32, NITEMS = I_IN + I_QK + I_PA + I_PM + I_OUT;
    for (int it = gw; it < NITEMS; it += NGW) {
        int r = it;
        if (r < I_IN) { const int kb = r / 320, nb = r % 320; const int c0 = 32 * nb + (32 * nb >= 8192 ? 8 : 0);
            transpose_item(a.in[I_WIN], PROJ_W, c0, 64 * kb, (bf16*)(a.ws + WS_WIN), 1024, 32 * nb, 1.f, scr, F.lane); continue; } r -= I_IN;
        if (r < I_QK) { const int isk = r >> 6, hd = (r >> 4) & 3, kb = (r >> 2) & 3, nb = r & 3;
            transpose_item(a.in[isk ? I_WMK : I_WMQ] + (size_t)hd * 256 * 128, 128, 32 * nb, 64 * kb, (bf16*)(a.ws + WS_WQK), 256, hd * 256 + isk * 128 + 32 * nb, isk ? 1.f : 0.08838834764831845f, scr, F.lane); continue; } r -= I_QK;
        if (r < I_PA) { const int kb = r / 32, nb = r % 32; transpose_item(a.in[I_WPA], 1024, 32 * nb, 64 * kb, (bf16*)(a.ws + WS_WPA), 512, 32 * nb, 1.f, scr, F.lane); continue; } r -= I_PA;
        if (r < I_PM) { const int kb = r / 32, nb = r % 32; transpose_item(a.in[I_WPM], 1024, 32 * nb, 64 * kb, (bf16*)(a.ws + WS_WPM), 1024, 32 * nb, 1.f, scr, F.lane); continue; } r -= I_PM;
        { const int kb = r / 32, nb = r % 32; transpose_item(a.in[I_WOUT], 1024, 32 * nb, 64 * kb, (bf16*)(a.ws + WS_WOUT), 1024, 32 * nb, 1.f, scr, F.lane); }
    }
    for (int it = gw; it < CP_ROWS / 4; it += NGW) {
        int row = it * 4; const float* src; float* dst; int Lb, per;
        if (row < CP_ROWS0) { src = a.in[I_KV128]; dst = a.out + O_KV128S; Lb = 128; per = 120; }
        else if (row < CP_ROWS0 + CP_ROWS1) { row -= CP_ROWS0; src = a.in[I_KV512]; dst = a.out + O_KV512S; Lb = 512; per = 504; }
        else { row -= CP_ROWS0 + CP_ROWS1; src = a.in[I_KV2048]; dst = a.out + O_KV2048S; Lb = 2048; per = 2040; }
        const int b = row / per, j = row % per;
        const f32x4* s4 = (const f32x4*)(src + ((size_t)b * Lb + j + 8) * 1024) + F.lane; f32x4* d4 = (f32x4*)(dst + ((size_t)b * Lb + j) * 1024) + F.lane;
        f32x4 v[16];
#pragma unroll
        for (int q = 0; q < 16; ++q) v[q] = __builtin_nontemporal_load(s4 + 64 * q);
#pragma unroll
        for (int q = 0; q < 16; ++q) __builtin_nontemporal_store(v[q], d4 + 64 * q);
    }
}

__device__ __forceinline__ void p1_hprep(const Args& a, Frame& F) {
    LAS float* mod = (LAS float*)F.lds;
    LAS float* W8 = mod + 4096;
    const float* adap = (const float*)(a.ws + WS_ADAP); const float* bada = a.in[I_BADA];
    for (int i = F.tid; i < 4096; i += NTHREADS) { const int b = i >> 11, which = (i >> 10) & 1, e = i & 1023; const int n = (which == 0 ? 1024 : 0) + e;
        float s = bada[n];
#pragma unroll
        for (int ks = 0; ks < 4; ++ks) s += adap[(size_t)(ks * 34 + b) * 3072 + n];
        mod[i] = which == 0 ? 1.f + s : s; }
    for (int i = F.tid; i < 8192; i += NTHREADS) { const int e = i >> 3, c = i & 7; W8[i] = a.in[I_WIN][(size_t)e * PROJ_W + 8192 + c]; }
    float* gate = (float*)(a.ws + WS_GATE);
    for (int i = F.vcu * NTHREADS + F.tid; i < NBATCH * 1024; i += F.G * NTHREADS) { const int b = i >> 10, n = 2048 + (i & 1023); float s = bada[n];
#pragma unroll
        for (int ks = 0; ks < 4; ++ks) s += adap[(size_t)(ks * 34 + b) * 3072 + n];
        gate[i] = s; }
    __syncthreads();
    const int gw = F.vcu * NWAVES + F.wave, NGW = F.G * NWAVES;
    const float* ng = a.in[I_NG];
    bf16* HN = (bf16*)(a.ws + WS_HN); float* GT = (float*)(a.ws + WS_GATES);
    for (int r = gw; r < M; r += NGW) {
        const float* xrow = r < MP ? a.in[I_XP] + (size_t)r * 1024 : a.in[I_XS] + (size_t)(r - MP) * 1024;
        f32x4 v[4]; float ssq = 0.f;
#pragma unroll
        for (int j = 0; j < 4; ++j) { v[j] = ((const f32x4*)xrow)[64 * j + F.lane]; ssq += (v[j].x * v[j].x + v[j].y * v[j].y) + (v[j].z * v[j].z + v[j].w * v[j].w); }
        const float rstd = rsqrtf(wave_sum(ssq) * (1.f / 1024.f) + EPS);
        float g[8];
#pragma unroll
        for (int c = 0; c < 8; ++c) g[c] = 0.f;
#pragma unroll
        for (int j = 0; j < 4; ++j) {
            const int e = 4 * (64 * j + F.lane);
            const f32x4 gn = *(const f32x4*)(ng + e);
            f32x4 sc1, sh;
            if (r < MP) { const int b = r >> 13; sc1 = *(const LAS f32x4*)(mod + (b * 2 + 0) * 1024 + e); sh = *(const LAS f32x4*)(mod + (b * 2 + 1) * 1024 + e); }
            else { const int b = 2 + ((r - MP) >> 3); sc1 = *(const f32x4*)(bada + 1024 + e); sh = *(const f32x4*)(bada + e);
#pragma unroll
                for (int ks = 0; ks < 4; ++ks) { sc1 += *(const f32x4*)(adap + (size_t)(ks * 34 + b) * 3072 + 1024 + e); sh += *(const f32x4*)(adap + (size_t)(ks * 34 + b) * 3072 + e); }
                sc1 += 1.f; }
            const f32x4 h = v[j] * rstd * gn * sc1 + sh;
            v2u o; o.x = pk2(h.x, h.y); o.y = pk2(h.z, h.w);
            *(v2u*)(HN + (size_t)r * 1024 + e) = o;
#pragma unroll
            for (int q = 0; q < 4; ++q) { const f32x4 w0 = *(const LAS f32x4*)(W8 + (e + q) * 8), w1 = *(const LAS f32x4*)(W8 + (e + q) * 8 + 4); const float hq = h[q];
                g[0] += hq * w0.x; g[1] += hq * w0.y; g[2] += hq * w0.z; g[3] += hq * w0.w; g[4] += hq * w1.x; g[5] += hq * w1.y; g[6] += hq * w1.z; g[7] += hq * w1.w; }
        }
#pragma unroll
        for (int c = 0; c < 8; ++c) g[c] = wave_sum(g[c]);
        if (F.lane == 0) { *(f32x4*)(GT + (size_t)r * 8) = (f32x4){g[0], g[1], g[2], g[3]}; *(f32x4*)(GT + (size_t)r * 8 + 4) = (f32x4){g[4], g[5], g[6], g[7]}; }
    }
}

struct EpiG1 {
    static constexpr bool PERM = true, AFTER_DRAIN = false;
    unsigned char* ws; float* out;
    template <int ACT> __device__ __forceinline__ void store(const pg8::f32x4 (&acc)[2][2][4][2], bf16* dst, int ldc, int row0, int col0) const {
#pragma unroll
        for (int ai = 0; ai < 2; ++ai)
#pragma unroll
            for (int m = 0; m < 4; ++m) { bf16* rowp = dst + (size_t)(row0 + ai * 128 + m * 16) * ldc + col0;
#pragma unroll
                for (int bj = 0; bj < 2; ++bj) { pg8::f32x4 v0 = acc[ai][bj][m][0], v1 = acc[ai][bj][m][1];
                    if (ACT == 1) {
#pragma unroll
                        for (int q = 0; q < 4; ++q) { v0[q] = siluf_(v0[q]); v1[q] = siluf_(v1[q]); } }
                    if (ACT == 2) {
#pragma unroll
                        for (int q = 0; q < 4; ++q) { v0[q] = sigmoidf_(v0[q]); v1[q] = sigmoidf_(v1[q]); } }
                    v4u w; w.x = pg8::cvt_pk_bf16(v0[0], v0[1]); w.y = pg8::cvt_pk_bf16(v0[2], v0[3]); w.z = pg8::cvt_pk_bf16(v1[0], v1[1]); w.w = pg8::cvt_pk_bf16(v1[2], v1[3]);
                    *(v4u*)(rowp + bj * 128) = w; } }
    }
    __device__ __forceinline__ void operator()(const pg8::f32x4 (&acc)[2][2][4][2], const pg8::Unit& u, int wr, int wc, int fr, int fq) const {
        const int pn = u.pn, row0 = u.pm * 256 + wr * 64 + fr, cin = wc * 32 + 8 * fq;
        if (pn < 18) store<0>(acc, (bf16*)(ws + WS_QKV), 4608, row0, pn * 256 + cin);
        else if (pn < 20) store<1>(acc, (bf16*)(ws + WS_ZA), 512, row0, (pn - 18) * 256 + cin);
        else if (pn < 24) store<0>(acc, (bf16*)(ws + WS_XM), 1024, row0, (pn - 20) * 256 + cin);
        else if (pn < 28) store<1>(acc, (bf16*)(ws + WS_ZM), 1024, row0, (pn - 24) * 256 + cin);
        else if (pn < 32) store<2>(acc, (bf16*)(ws + WS_OM), 1024, row0, (pn - 28) * 256 + cin);
        else if (pn < 36) store<2>(acc, (bf16*)(ws + WS_GA), 1024, row0, (pn - 32) * 256 + cin);
        else store<2>(acc, (bf16*)(ws + WS_GM), 1024, row0, (pn - 36) * 256 + cin);
        if (pn >= 6 && pn < 18) {
            const int isv = (pn - 6) / 6, gi = ((pn - 6) % 6) >> 1, half = (pn - 6) & 1, keep = 128 << (2 * gi);
            const int t0 = (u.pm & 31) * 256;
            if (u.pm == 64 || t0 + 256 > SEQ - keep) {
                float* kvp = out + (gi == 0 ? O_KV128P : gi == 1 ? O_KV512P : O_KV2048P); float* kvs = out + (gi == 0 ? O_KV128S : gi == 1 ? O_KV512S : O_KV2048S);
                const int dcol = isv * 512 + half * 256 + cin;
#pragma unroll
                for (int ai = 0; ai < 2; ++ai)
#pragma unroll
                    for (int m = 0; m < 4; ++m) { const int r = row0 + ai * 128 + m * 16; float* drow = nullptr;
                        if (r < MP) { const int b = r >> 13, t = r & (SEQ - 1); if (t >= SEQ - keep) drow = kvp + ((size_t)b * keep + (t - (SEQ - keep))) * 1024; }
                        else { const int rs = r - MP, b = rs >> 3, t = rs & 7; drow = kvs + ((size_t)b * keep + (keep - 8 + t)) * 1024; }
                        if (drow) {
#pragma unroll
                            for (int bj = 0; bj < 2; ++bj) { *(pg8::f32x4*)(drow + dcol + bj * 128) = acc[ai][bj][m][0]; *(pg8::f32x4*)(drow + dcol + bj * 128 + 4) = acc[ai][bj][m][1]; } } }
            }
        }
        if (pn >= 20 && pn < 24 && (u.pm == 64 || (u.pm & 31) == 31)) {
            const int dcol = (pn - 20) * 256 + cin;
#pragma unroll
            for (int ai = 0; ai < 2; ++ai)
#pragma unroll
                for (int m = 0; m < 4; ++m) { const int r = row0 + ai * 128 + m * 16; float* drow = nullptr;
                    if (r < MP) { const int b = r >> 13, t = r & (SEQ - 1); if (t >= SEQ - 3) drow = out + O_CONVP + ((size_t)b * 3 + (t - (SEQ - 3))) * 1024; }
                    else { const int rs = r - MP, b = rs >> 3, t = rs & 7; if (t >= 5) drow = out + O_CONVS + ((size_t)b * 3 + (t - 5)) * 1024; }
                    if (drow) {
#pragma unroll
                        for (int bj = 0; bj < 2; ++bj) { *(pg8::f32x4*)(drow + dcol + bj * 128) = acc[ai][bj][m][0]; *(pg8::f32x4*)(drow + dcol + bj * 128 + 4) = acc[ai][bj][m][1]; } } }
        }
    }
};

__device__ __forceinline__ void conv_task(const Args& a, Frame& F, int task) {
    const bf16* XM = (const bf16*)(a.ws + WS_XM); bf16* CA = (bf16*)(a.ws + WS_CACT);
    const float* cw = a.in[I_CONVW]; const float* cb = a.in[I_CONVB];
    const int r0 = (task >> 1) * 8, c0 = (task & 1) * 512 + 8 * F.lane;
    const bool samp = r0 >= MP; const int t0 = samp ? 0 : (r0 & (SEQ - 1));
    float x[11][8];
#pragma unroll
    for (int i = 0; i < 11; ++i) {
        if (i >= 3 || t0 > 0) { const v4u u = *(const v4u*)(XM + (size_t)(r0 - 3 + i) * 1024 + c0);
            x[i][0] = bflo(u.x); x[i][1] = bfhi(u.x); x[i][2] = bflo(u.y); x[i][3] = bfhi(u.y); x[i][4] = bflo(u.z); x[i][5] = bfhi(u.z); x[i][6] = bflo(u.w); x[i][7] = bfhi(u.w); }
        else if (samp) { const float* sp = a.in[I_SCONV] + ((size_t)((r0 - MP) >> 3) * 3 + i) * 1024 + c0; const f32x4 x0 = *(const f32x4*)sp, x1 = *(const f32x4*)(sp + 4);
            x[i][0] = x0.x; x[i][1] = x0.y; x[i][2] = x0.z; x[i][3] = x0.w; x[i][4] = x1.x; x[i][5] = x1.y; x[i][6] = x1.z; x[i][7] = x1.w; }
        else {
#pragma unroll
            for (int q = 0; q < 8; ++q) x[i][q] = 0.f; }
    }
    float w[4][8], bias[8];
#pragma unroll
    for (int j = 0; j < 4; ++j) { const f32x4 x0 = *(const f32x4*)(cw + j * 1024 + c0), x1 = *(const f32x4*)(cw + j * 1024 + c0 + 4);
        w[j][0] = x0.x; w[j][1] = x0.y; w[j][2] = x0.z; w[j][3] = x0.w; w[j][4] = x1.x; w[j][5] = x1.y; w[j][6] = x1.z; w[j][7] = x1.w; }
    { const f32x4 x0 = *(const f32x4*)(cb + c0), x1 = *(const f32x4*)(cb + c0 + 4); bias[0] = x0.x; bias[1] = x0.y; bias[2] = x0.z; bias[3] = x0.w; bias[4] = x1.x; bias[5] = x1.y; bias[6] = x1.z; bias[7] = x1.w; }
#pragma unroll
    for (int i = 0; i < 8; ++i) {
        float acc[8];
#pragma unroll
        for (int q = 0; q < 8; ++q) acc[q] = bias[q] + w[0][q] * x[i][q] + w[1][q] * x[i + 1][q] + w[2][q] * x[i + 2][q] + w[3][q] * x[i + 3][q];
        v4u o; o.x = pk2(siluf_(acc[0]), siluf_(acc[1])); o.y = pk2(siluf_(acc[2]), siluf_(acc[3])); o.z = pk2(siluf_(acc[4]), siluf_(acc[5])); o.w = pk2(siluf_(acc[6]), siluf_(acc[7]));
        *(v4u*)(CA + (size_t)(r0 + i) * 1024 + c0) = o;
    }
}

__device__ __forceinline__ int t5_bucket(int n) {
    if (n < 16) return n;
    int b = 16;
    b += (n >= 22) + (n >= 30) + (n >= 40) + (n >= 54) + (n >= 73) + (n >= 99) + (n >= 134) + (n >= 182) + (n >= 246) + (n >= 332) + (n >= 450) + (n >= 609) + (n >= 825) + (n >= 1117) + (n >= 1513);
    return b;
}

__device__ __forceinline__ void attn_valu_task(const Args& a, Frame& F, int row, int g, int h, LAS float* pscr) {
    const bf16* QKV = (const bf16*)(a.ws + WS_QKV);
    const int d = 1 << (2 * g), Lb = 128 << (2 * g);
    const int b = (row - MP) >> 3, t = (row - MP) & 7, jn = t / d;
    const float* cache = a.in[g == 0 ? I_KV128 : g == 1 ? I_KV512 : I_KV2048] + (size_t)b * Lb * 1024 + h * 64;
    const bf16* newkv = QKV + (size_t)(MP + b * 8) * 4608 + g * 512 + h * 64;
    const float* rel = a.in[I_REL] + g * 8 + h;
    LAS float* qs = pscr + 160;
    const float qv = bf1(QKV[(size_t)row * 4608 + g * 512 + h * 64 + F.lane]);
    qs[F.lane] = qv;
    LDS_WAIT(); asm volatile("" ::: "memory");
    float sc[2];
#pragma unroll
    for (int it = 0; it < 2; ++it) {
        const int j = 64 * it + F.lane, p = Lb + t - d * j; float dot = 0.f;
        if (j <= jn) { const bf16* kp = newkv + (size_t)(p - Lb) * 4608 + 1536;
#pragma unroll
            for (int c = 0; c < 8; ++c) { const v4u u = *(const v4u*)(kp + 8 * c); const f32x4 q0 = *(const LAS f32x4*)(qs + 8 * c), q1 = *(const LAS f32x4*)(qs + 8 * c + 4);
                dot += q0.x * bflo(u.x) + q0.y * bfhi(u.x) + q0.z * bflo(u.y) + q0.w * bfhi(u.y) + q1.x * bflo(u.z) + q1.y * bfhi(u.z) + q1.z * bflo(u.w) + q1.w * bfhi(u.w); } }
        else { const float* kp = cache + (size_t)p * 1024; f32x4 kv[16];
#pragma unroll
            for (int c = 0; c < 16; ++c) kv[c] = *(const f32x4*)(kp + 4 * c);
#pragma unroll
            for (int c = 0; c < 16; ++c) { const f32x4 q = *(const LAS f32x4*)(qs + 4 * c); dot += q.x * kv[c].x + q.y * kv[c].y + q.z * kv[c].z + q.w * kv[c].w; } }
        sc[it] = dot * 0.125f + rel[t5_bucket(d * j) * 24];
    }
    const float s128 = wave_sum(qv * cache[(size_t)t * 1024 + F.lane]) * 0.125f + rel[t5_bucket(d * 128) * 24];
    const float mx = fmaxf(wave_max(fmaxf(sc[0], sc[1])), s128);
    const float p0 = __expf(sc[0] - mx), p1 = __expf(sc[1] - mx), p128 = __expf(s128 - mx);
    const float l = wave_sum(p0 + p1) + p128;
    pscr[F.lane] = p0; pscr[64 + F.lane] = p1;
    LDS_WAIT(); asm volatile("" ::: "memory");
    float o = p128 * cache[(size_t)t * 1024 + 512 + F.lane];
    for (int j = 0; j <= jn; ++j) o += pscr[j] * bf1(newkv[(size_t)(t - d * j) * 4608 + 3072 + F.lane]);
    const float* vp = cache + (size_t)(Lb + t) * 1024 + 512 + F.lane;
    int j = jn + 1;
    for (; j + 40 <= 128; j += 40) { float vv[40];
#pragma unroll
        for (int c = 0; c < 40; ++c) vv[c] = vp[-(ptrdiff_t)(j + c) * d * 1024];
#pragma unroll
        for (int c = 0; c < 40; ++c) o += pscr[j + c] * vv[c]; }
    for (; j < 128; ++j) o += pscr[j] * vp[-(ptrdiff_t)j * d * 1024];
    o *= fast_rcp(l);
    ((bf16*)(a.ws + WS_OG))[(size_t)row * 1536 + g * 512 + h * 64 + F.lane] = (bf16)f2bf(o);
    if (F.lane == 0) ((float*)(a.ws + WS_LSE))[(size_t)row * 24 + g * 8 + h] = mx + __logf(l);
    LDS_WAIT(); asm volatile("" ::: "memory");
}

constexpr int AT_K_OFF = 0, AT_KROW = 144, AT_V_OFF = 384 * AT_KROW, AT_VPLANE = 384 * 64, AT_TB_OFF = AT_V_OFF + 2 * AT_VPLANE, AT_LDS_END = AT_TB_OFF + 192 * 4;
static_assert(AT_LDS_END <= RING_BYTES, "attention LDS");
__device__ __forceinline__ int crow(int r, int hi) { return (r & 3) + 8 * (r >> 2) + 4 * hi; }
typedef short v4i16_t __attribute__((ext_vector_type(4)));
__device__ __forceinline__ s16x4 tr_read(const LAS unsigned char* p) { return __builtin_bit_cast(s16x4, __builtin_amdgcn_ds_read_tr16_b64_v4i16((LAS v4i16_t*)p)); }
constexpr int NAU = NBP * 3 * 8 * 32, ATT_P5 = 384;
struct AttnDec { int b, g, h, d, np, r; };
__device__ __forceinline__ AttnDec attn_decode(int au) {
    AttnDec u; const int pr = au & 31, bgh = au >> 5, bg = bgh >> 3; u.h = bgh & 7; u.g = bg % 3; u.b = bg / 3;
    u.d = 1 << (2 * u.g); const int ppr = 32 >> (2 * u.g); u.np = pr & (ppr - 1); u.r = pr >> (5 - 2 * u.g); return u;
}
__device__ __forceinline__ void attn_load(const bf16* QKV, const AttnDec& u, int tid, int wave, int lane, v4u (&kreg)[6], v4u (&vreg)[6], bf16x8 (&qn)[4]) {
    const size_t colq = (size_t)u.g * 512 + u.h * 64;
#pragma unroll
    for (int k = 0; k < 6; ++k) { const int i = tid + NTHREADS * k, c = i >> 3, ch = i & 7, uu = 256 * u.np - 128 + c;
        kreg[k] = (v4u){0u, 0u, 0u, 0u}; vreg[k] = (v4u){0u, 0u, 0u, 0u};
        if (uu >= 0) { const bf16* rp = QKV + ((size_t)u.b * SEQ + (size_t)uu * u.d + u.r) * 4608 + colq + 8 * ch; kreg[k] = *(const v4u*)(rp + 1536); vreg[k] = *(const v4u*)(rp + 3072); } }
    const size_t qrow = (size_t)u.b * SEQ + (size_t)(256 * u.np + 32 * wave + (lane & 31)) * u.d + u.r;
#pragma unroll
    for (int s = 0; s < 4; ++s) qn[s] = *(const bf16x8*)(QKV + qrow * 4608 + colq + 16 * s + 8 * (lane >> 5));
}
__device__ __forceinline__ void attn_prompt_phase(const Args& a, Frame& F, int first, int stride, int end) {
    const bf16* QKV = (const bf16*)(a.ws + WS_QKV);
    LAS unsigned char* Kl = F.lds + AT_K_OFF; LAS unsigned char* Vl = F.lds + AT_V_OFF; LAS float* tb = (LAS float*)(F.lds + AT_TB_OFF);
    v4u kreg[6], vreg[6]; bf16x8 qn[4];
    int au = first;
    if (au < end) attn_load(QKV, attn_decode(au), F.tid, F.wave, F.lane, kreg, vreg, qn);
    for (; au < end; au += stride) {
        const AttnDec U = attn_decode(au); const int b = U.b, g = U.g, h = U.h, d = U.d, np = U.np, r = U.r;
        const size_t colq = (size_t)g * 512 + h * 64;
        __syncthreads();
#pragma unroll
        for (int k = 0; k < 6; ++k) { const int i = F.tid + NTHREADS * k, c = i >> 3, ch = i & 7;
            *(LAS v4u*)(Kl + c * AT_KROW + ch * 16) = kreg[k];
            *(LAS v4u*)(Vl + (ch >> 2) * AT_VPLANE + c * 64 + (ch & 3) * 16) = vreg[k]; }
    if (F.tid < 192) { const int dist = 160 - F.tid; tb[F.tid] = (dist >= 0 && dist <= 128) ? a.in[I_REL][t5_bucket(dist * d) * 24 + g * 8 + h] * 1.4426950408889634f : -INFINITY; }
        __syncthreads();
        bf16x8 qf[4];
#pragma unroll
        for (int s = 0; s < 4; ++s) qf[s] = qn[s];
        if (au + stride < end) attn_load(QKV, attn_decode(au + stride), F.tid, F.wave, F.lane, kreg, vreg, qn);
    int l = F.lane; asm volatile("" : "+v"(l));
    const int w = F.wave, i = l & 31, hh = l >> 5;
        const size_t qrow = (size_t)b * SEQ + (size_t)(256 * np + 32 * w + i) * d + r;
    f32x16 st[5];
#pragma unroll
    for (int kt = 0; kt < 5; ++kt) {
        f32x16 acc = {0.f, 0.f, 0.f, 0.f, 0.f, 0.f, 0.f, 0.f, 0.f, 0.f, 0.f, 0.f, 0.f, 0.f, 0.f, 0.f};
#pragma unroll
        for (int s = 0; s < 4; ++s) { const bf16x8 kf = *(const LAS bf16x8*)(Kl + (32 * w + 32 * kt + i) * AT_KROW + (16 * s + 8 * hh) * 2); acc = __builtin_amdgcn_mfma_f32_32x32x16_bf16(kf, qf[s], acc, 0, 0, 0); }
        st[kt] = acc;
        __builtin_amdgcn_sched_barrier(0);
    }
    const float C2 = 0.125f * 1.4426950408889634f;
    const LAS float* tbl = tb + (32 - i + 4 * hh);
    float mx = -INFINITY;
#pragma unroll
    for (int kt = 0; kt < 5; ++kt) {
#pragma unroll
        for (int rg = 0; rg < 16; ++rg) { const float x = st[kt][rg] * C2 + tbl[32 * kt + (rg & 3) + 8 * (rg >> 2)]; st[kt][rg] = x; }
    }
    if (np == 0 && w < 4) {
        const int cmin = 128 - 32 * w - 4 * hh;
#pragma unroll
        for (int kt = 0; kt < 4; ++kt)
#pragma unroll
            for (int rg = 0; rg < 16; ++rg) if (32 * kt + (rg & 3) + 8 * (rg >> 2) < cmin) st[kt][rg] = -INFINITY;
    }
#pragma unroll
    for (int kt = 0; kt < 5; ++kt)
#pragma unroll
        for (int rg = 0; rg < 16; ++rg) mx = fmaxf(mx, st[kt][rg]);
    mx = fmaxf(mx, __shfl_xor(mx, 32));
    float lsum = 0.f;
#pragma unroll
    for (int kt = 0; kt < 5; ++kt)
#pragma unroll
        for (int rg = 0; rg < 16; ++rg) { const float p = __builtin_amdgcn_exp2f(st[kt][rg] - mx); st[kt][rg] = p; lsum += p; }
    lsum += __shfl_xor(lsum, 32);
    f32x16 oacc[2];
#pragma unroll
    for (int et = 0; et < 2; ++et) oacc[et] = (f32x16){0.f, 0.f, 0.f, 0.f, 0.f, 0.f, 0.f, 0.f, 0.f, 0.f, 0.f, 0.f, 0.f, 0.f, 0.f, 0.f};
    const int i16 = l & 15, qq = i16 >> 2, pp = i16 & 3, g1 = (l >> 4) & 1;
    const LAS unsigned char* vb = Vl + (32 * w + 4 * hh + qq) * 64 + (16 * g1 + 4 * pp) * 2;
#pragma unroll
    for (int kt = 0; kt < 5; ++kt)
#pragma unroll
        for (int s = 0; s < 2; ++s) {
            v4u pw; pw.x = pg8::cvt_pk_bf16(st[kt][8 * s + 0], st[kt][8 * s + 1]); pw.y = pg8::cvt_pk_bf16(st[kt][8 * s + 2], st[kt][8 * s + 3]);
            pw.z = pg8::cvt_pk_bf16(st[kt][8 * s + 4], st[kt][8 * s + 5]); pw.w = pg8::cvt_pk_bf16(st[kt][8 * s + 6], st[kt][8 * s + 7]);
            const bf16x8 pf = __builtin_bit_cast(bf16x8, pw);
#pragma unroll
            for (int et = 0; et < 2; ++et) {
                const s16x4 lo = tr_read(vb + et * AT_VPLANE + (32 * kt + 16 * s) * 64), hi = tr_read(vb + et * AT_VPLANE + (32 * kt + 16 * s) * 64 + 512);
                const bf16x8 vf = (bf16x8){lo[0], lo[1], lo[2], lo[3], hi[0], hi[1], hi[2], hi[3]};
                oacc[et] = __builtin_amdgcn_mfma_f32_32x32x16_bf16(vf, pf, oacc[et], 0, 0, 0);
            }
            __builtin_amdgcn_sched_barrier(0);
        }
    const float inv = fast_rcp(lsum);
    bf16* orow = (bf16*)(a.ws + WS_OG) + qrow * 1536 + colq;
#pragma unroll
    for (int et = 0; et < 2; ++et)
#pragma unroll
        for (int rg = 0; rg < 4; ++rg) { v2u o; o.x = pg8::cvt_pk_bf16(oacc[et][4 * rg] * inv, oacc[et][4 * rg + 1] * inv); o.y = pg8::cvt_pk_bf16(oacc[et][4 * rg + 2] * inv, oacc[et][4 * rg + 3] * inv);
            *(v2u*)(orow + 32 * et + 8 * rg + 4 * hh) = o; }
    if (hh == 0) ((float*)(a.ws + WS_LSE))[qrow * 24 + g * 8 + h] = (mx + __log2f(lsum)) * 0.6931471805599453f;
    }
    __syncthreads();
}
__device__ __forceinline__ void combine_rows(const Args& a, Frame& F, int row_lo, int row_hi) {
    const bf16* OG = (const bf16*)(a.ws + WS_OG); const float* LSE = (const float*)(a.ws + WS_LSE); const bf16* ZA = (const bf16*)(a.ws + WS_ZA); bf16* A3 = (bf16*)(a.ws + WS_A3);
    for (size_t i = (size_t)F.vcu * NTHREADS + F.tid; i < (size_t)(row_hi - row_lo) * 64; i += (size_t)F.G * NTHREADS) {
        const int row = row_lo + (int)(i >> 6), ch = (int)(i & 63) * 8, h = ch >> 6;
        const float l0 = LSE[(size_t)row * 24 + h], l1 = LSE[(size_t)row * 24 + 8 + h], l2 = LSE[(size_t)row * 24 + 16 + h];
        const float mx = fmaxf(l0, fmaxf(l1, l2)); float a0 = __expf(l0 - mx), a1 = __expf(l1 - mx), a2 = __expf(l2 - mx); const float inv = fast_rcp(a0 + a1 + a2); a0 *= inv; a1 *= inv; a2 *= inv;
        const v4u o0 = *(const v4u*)(OG + (size_t)row * 1536 + ch), o1 = *(const v4u*)(OG + (size_t)row * 1536 + 512 + ch), o2 = *(const v4u*)(OG + (size_t)row * 1536 + 1024 + ch), z = *(const v4u*)(ZA + (size_t)row * 512 + ch);
        v4u r;
#pragma unroll
        for (int q = 0; q < 4; ++q) { const float lo = (a0 * bflo(o0[q]) + a1 * bflo(o1[q]) + a2 * bflo(o2[q])) * bflo(z[q]), hi = (a0 * bfhi(o0[q]) + a1 * bfhi(o1[q]) + a2 * bfhi(o2[q])) * bfhi(z[q]); r[q] = pk2(lo, hi); }
        *(v4u*)(A3 + (size_t)row * 512 + ch) = r;
    }
}

__device__ __forceinline__ void mlstm_recurrent_unit(const Args& a, Frame& F, int row0, int T, int hd, const float* C0, const float* n0, const float* m0p, float* Cout, float* nout, float* mout) {
    const bf16* QM = (const bf16*)(a.ws + WS_QM); const bf16* KM = (const bf16*)(a.ws + WS_KM); const bf16* XM = (const bf16*)(a.ws + WS_XM);
    const bf16* OM = (const bf16*)(a.ws + WS_OM); const bf16* ZM = (const bf16*)(a.ws + WS_ZM); const bf16* CA = (const bf16*)(a.ws + WS_CACT); bf16* A4 = (bf16*)(a.ws + WS_A4);
    const float* GT = (const float*)(a.ws + WS_GATES); const float* bif = a.in[I_BIF];
    LAS float* qs = (LAS float*)F.lds;
    LAS float* ks = qs + 16 * 128;
    LAS float* vs = ks + 16 * 128;
    LAS float* hs = vs + 16 * 256;
    LAS float* gs = hs + 16 * 256;
    const int v = F.tid >> 1, kh = F.tid & 1;
    float C[64], n[64]; float m;
    if (C0) {
#pragma unroll
        for (int c = 0; c < 16; ++c) { const f32x4 x = *(const f32x4*)(C0 + (size_t)v * 128 + 64 * kh + 4 * c); C[4 * c] = x.x; C[4 * c + 1] = x.y; C[4 * c + 2] = x.z; C[4 * c + 3] = x.w; }
#pragma unroll
        for (int c = 0; c < 16; ++c) { const f32x4 x = *(const f32x4*)(n0 + 64 * kh + 4 * c); n[4 * c] = x.x; n[4 * c + 1] = x.y; n[4 * c + 2] = x.z; n[4 * c + 3] = x.w; }
        m = *m0p;
    } else {
#pragma unroll
        for (int c = 0; c < 64; ++c) { C[c] = 0.f; n[c] = 0.f; }
        m = 0.f;
    }
    for (int tb = 0; tb < T; tb += 16) {
        const int nb = min(16, T - tb);
        __syncthreads();
        for (int i = F.tid; i < nb * 128; i += NTHREADS) { const int tt = i >> 7, k = i & 127; const size_t r = (size_t)(row0 + tb + tt);
            qs[tt * 128 + k] = bf1(QM[r * 512 + hd * 128 + k]); ks[tt * 128 + k] = bf1(KM[r * 512 + hd * 128 + k]); }
        for (int i = F.tid; i < nb * 256; i += NTHREADS) { const int tt = i >> 8, vv = i & 255; vs[tt * 256 + vv] = bf1(XM[(size_t)(row0 + tb + tt) * 1024 + hd * 256 + vv]); }
        if (F.tid < nb) { const size_t r = (size_t)(row0 + tb + F.tid); gs[2 * F.tid] = GT[r * 8 + hd] + bif[hd]; gs[2 * F.tid + 1] = logsigmoidf_(GT[r * 8 + 4 + hd] + bif[4 + hd]); }
        __syncthreads();
        for (int tt = 0; tt < nb; ++tt) {
            const float ig = gs[2 * tt], lf = gs[2 * tt + 1];
            const float mn = fmaxf(lf + m, ig), fw = __expf(lf + m - mn), iw = __expf(ig - mn); m = mn;
            const float vv = vs[tt * 256 + v] * iw;
            float num = 0.f, den = 0.f;
#pragma unroll
            for (int c = 0; c < 16; ++c) {
                const f32x4 kk = *(const LAS f32x4*)(ks + tt * 128 + 64 * kh + 4 * c), qq = *(const LAS f32x4*)(qs + tt * 128 + 64 * kh + 4 * c);
#pragma unroll
                for (int e = 0; e < 4; ++e) { C[4 * c + e] = fw * C[4 * c + e] + vv * kk[e]; n[4 * c + e] = fw * n[4 * c + e] + iw * kk[e]; num += C[4 * c + e] * qq[e]; den += n[4 * c + e] * qq[e]; }
            }
            num += __shfl_xor(num, 1); den += __shfl_xor(den, 1);
            const float hh = num / fmaxf(fabsf(den), __expf(-mn));
            if (kh == 0) hs[tt * 256 + v] = hh;
        }
        __syncthreads();
        for (int tt = F.wave; tt < nb; tt += NWAVES) {
            const f32x4 x = *(const LAS f32x4*)(hs + tt * 256 + 4 * F.lane);
            const float mu = wave_sum((x.x + x.y) + (x.z + x.w)) * (1.f / 256.f);
            const f32x4 dx = x - mu;
            const float var = wave_sum((dx.x * dx.x + dx.y * dx.y) + (dx.z * dx.z + dx.w * dx.w)) * (1.f / 256.f);
            const float rs = rsqrtf(var + EPS);
            const size_t r = (size_t)(row0 + tb + tt); const int ch = hd * 256 + 4 * F.lane;
            const v2u om = *(const v2u*)(OM + r * 1024 + ch), zm = *(const v2u*)(ZM + r * 1024 + ch), ca = *(const v2u*)(CA + r * 1024 + ch);
            const f32x4 mnw = *(const f32x4*)(a.in[I_MNORM] + ch), msk = *(const f32x4*)(a.in[I_MSKIP] + ch);
            const float o0 = (bflo(om.x) * (dx.x * rs) * mnw.x + msk.x * bflo(ca.x)) * bflo(zm.x), o1 = (bfhi(om.x) * (dx.y * rs) * mnw.y + msk.y * bfhi(ca.x)) * bfhi(zm.x);
            const float o2 = (bflo(om.y) * (dx.z * rs) * mnw.z + msk.z * bflo(ca.y)) * bflo(zm.y), o3 = (bfhi(om.y) * (dx.w * rs) * mnw.w + msk.w * bfhi(ca.y)) * bfhi(zm.y);
            v2u o; o.x = pk2(o0, o1); o.y = pk2(o2, o3);
            *(v2u*)(A4 + r * 1024 + ch) = o;
        }
    }
#pragma unroll
    for (int c = 0; c < 16; ++c) *(f32x4*)(Cout + (size_t)v * 128 + 64 * kh + 4 * c) = (f32x4){C[4 * c], C[4 * c + 1], C[4 * c + 2], C[4 * c + 3]};
    if (v == 0) {
#pragma unroll
        for (int c = 0; c < 16; ++c) *(f32x4*)(nout + 64 * kh + 4 * c) = (f32x4){n[4 * c], n[4 * c + 1], n[4 * c + 2], n[4 * c + 3]};
        if (kh == 0) *mout = m;
    }
    __syncthreads();
}

constexpr int ML_VP = 0, ML_PLANE = 128 * 64, ML_KP = 8 * ML_PLANE;
constexpr int ML_KROW = 272, ML_ARR = ML_KP + 128 * ML_KROW;
constexpr int ML_HROW = 528;
static_assert(ML_ARR + 6 * 512 + 2048 <= RING_BYTES && 128 * ML_HROW <= ML_ARR, "mLSTM LDS");

__device__ __forceinline__ void ml_gates(const Args& a, Frame& F, int row0, int hd, LAS float* as, LAS float* bs, LAS float* cms, LAS float* tmp) {
    const float* GT = (const float*)(a.ws + WS_GATES); const float* bif = a.in[I_BIF];
    float ig = 0.f, x = 0.f;
    if (F.tid < 128) { const size_t r = (size_t)(row0 + F.tid); ig = GT[r * 8 + hd] + bif[hd]; x = logsigmoidf_(GT[r * 8 + 4 + hd] + bif[4 + hd]); }
#pragma unroll
    for (int o = 1; o < 64; o <<= 1) { const float y = __shfl_up(x, o); if (F.lane >= o) x += y; }
    if (F.tid == 63) tmp[0] = x;
    __syncthreads();
    if (F.wave == 1) x += tmp[0];
    const float av = ig - x; float cm = av;
#pragma unroll
    for (int o = 1; o < 64; o <<= 1) { const float y = __shfl_up(cm, o); if (F.lane >= o) cm = fmaxf(cm, y); }
    if (F.tid == 63) tmp[1] = cm;
    __syncthreads();
    if (F.wave == 1) cm = fmaxf(cm, tmp[1]);
    if (F.tid < 128) { as[F.tid] = av; bs[F.tid] = x; cms[F.tid] = cm; }
    __syncthreads();
}

__device__ __forceinline__ void ml_dc_unit(const Args& a, Frame& F, int unit) {
    const int c = unit & 63, bh = unit >> 6, hd = bh & 3, b = bh >> 2, row0 = b * SEQ + c * 128;
    const bf16* XM = (const bf16*)(a.ws + WS_XM); const bf16* KM = (const bf16*)(a.ws + WS_KM);
    LAS float* as = (LAS float*)(F.lds + ML_ARR); LAS float* bs = as + 256; LAS float* wk = as + 384;
    __syncthreads();
    ml_gates(a, F, row0, hd, as, bs, as + 128, as + 512);
    const float A = as[128 + 127];
    if (F.tid < 128) wk[F.tid] = __expf(as[F.tid] - A);
    if (F.tid == 0) { float* ch = (float*)(a.ws + WS_CHST) + (size_t)unit * 2; ch[0] = bs[127]; ch[1] = A; }
    __syncthreads();
    for (int i = F.tid; i < 128 * 32; i += NTHREADS) { const int s = i >> 5, ch = i & 31; const float w = wk[s];
        const v4u u = *(const v4u*)(XM + (size_t)(row0 + s) * 1024 + hd * 256 + 8 * ch); v4u o;
#pragma unroll
        for (int q = 0; q < 4; ++q) o[q] = pk2(bflo(u[q]) * w, bfhi(u[q]) * w);
        *(LAS v4u*)(F.lds + ML_VP + (ch >> 2) * ML_PLANE + s * 64 + (ch & 3) * 16) = o; }
    for (int i = F.tid; i < 128 * 16; i += NTHREADS) { const int s = i >> 4, ch = i & 15;
        *(LAS v4u*)(F.lds + ML_KP + (ch >> 2) * ML_PLANE + s * 64 + (ch & 3) * 16) = *(const v4u*)(KM + (size_t)(row0 + s) * 512 + hd * 128 + 8 * ch); }
    __syncthreads();
    int l = F.lane; asm volatile("" : "+v"(l));
    const int w = F.wave, hh = l >> 5, i16 = l & 15, qq = i16 >> 2, pp = i16 & 3, g1 = (l >> 4) & 1;
    const LAS unsigned char* tb0 = F.lds + (8 * hh + qq) * 64 + (16 * g1 + 4 * pp) * 2;
    f32x16 acc[4];
#pragma unroll
    for (int kt = 0; kt < 4; ++kt) acc[kt] = (f32x16){0.f, 0.f, 0.f, 0.f, 0.f, 0.f, 0.f, 0.f, 0.f, 0.f, 0.f, 0.f, 0.f, 0.f, 0.f, 0.f};
#pragma unroll
    for (int ks = 0; ks < 8; ++ks) {
        const s16x4 blo = tr_read(tb0 + ML_VP + w * ML_PLANE + ks * 1024), bhi = tr_read(tb0 + ML_VP + w * ML_PLANE + ks * 1024 + 256);
        const bf16x8 vf = (bf16x8){blo[0], blo[1], blo[2], blo[3], bhi[0], bhi[1], bhi[2], bhi[3]};
#pragma unroll
        for (int kt = 0; kt < 4; ++kt) {
            const s16x4 alo = tr_read(tb0 + ML_KP + kt * ML_PLANE + ks * 1024), ahi = tr_read(tb0 + ML_KP + kt * ML_PLANE + ks * 1024 + 256);
            const bf16x8 kf = (bf16x8){alo[0], alo[1], alo[2], alo[3], ahi[0], ahi[1], ahi[2], ahi[3]};
            acc[kt] = __builtin_amdgcn_mfma_f32_32x32x16_bf16(kf, vf, acc[kt], 0, 0, 0);
        }
    }
    bf16* dcp = (bf16*)(a.ws + WS_DCP) + ((size_t)unit * 256 + 32 * w + (l & 31)) * 128;
#pragma unroll
    for (int kt = 0; kt < 4; ++kt)
#pragma unroll
        for (int rg = 0; rg < 4; ++rg) { v2u o; o.x = pg8::cvt_pk_bf16(acc[kt][4 * rg], acc[kt][4 * rg + 1]); o.y = pg8::cvt_pk_bf16(acc[kt][4 * rg + 2], acc[kt][4 * rg + 3]);
            *(v2u*)(dcp + 32 * kt + 8 * rg + 4 * hh) = o; }
    if (F.tid < 128) { const int k = F.tid; float s = 0.f; const LAS bf16* kp = (const LAS bf16*)(F.lds + ML_KP + (k >> 5) * ML_PLANE) + (k & 31);
        for (int t = 0; t < 128; ++t) s += wk[t] * bf1(kp[t * 32]);
        ((float*)(a.ws + WS_DNP))[(size_t)unit * 128 + k] = s; }
}

__device__ __forceinline__ void ml_cscan(const Args& a, Frame& F) {
    LAS float* wC = (LAS float*)F.lds; LAS float* f1 = wC + 64;
    const unsigned* DCP = (const unsigned*)(a.ws + WS_DCP); unsigned* CPV = (unsigned*)(a.ws + WS_CPREV);
    const float* CH = (const float*)(a.ws + WS_CHST);
    for (int blk = F.vcu; blk < 8 * 32; blk += F.G) {
        const int bh = blk >> 5, e2 = (blk & 31) * 512 + F.tid;
        __syncthreads();
        if (F.tid == 0) { float m = 0.f;
            for (int c = 0; c < 64; ++c) { const float bL = CH[(size_t)(bh * 64 + c) * 2], A = CH[(size_t)(bh * 64 + c) * 2 + 1], Ml = fmaxf(m, A);
                wC[c] = __expf(m - Ml); f1[c] = __expf(A - Ml);
                if ((blk & 31) == 0) ((float*)(a.ws + WS_MPREV))[bh * 64 + c] = m;
                m = bL + Ml; }
            if ((blk & 31) == 0) a.out[O_MP + bh] = m; }
        __syncthreads();
        float c0 = 0.f, c1 = 0.f;
#pragma unroll 8
        for (int c = 0; c < 64; ++c) { const size_t off = (size_t)(bh * 64 + c) * 16384 + e2;
            CPV[off] = pk2(c0, c1); const unsigned dd = DCP[off];
            c0 = wC[c] * c0 + f1[c] * bflo(dd); c1 = wC[c] * c1 + f1[c] * bfhi(dd); }
        *(float2*)(a.out + O_CSTP + (size_t)bh * 32768 + 2 * e2) = make_float2(c0, c1);
        if ((blk & 31) == 0 && F.tid < 128) { float n = 0.f; const float* DN = (const float*)(a.ws + WS_DNP); float* NP = (float*)(a.ws + WS_NPREV);
            for (int c = 0; c < 64; ++c) { NP[(size_t)(bh * 64 + c) * 128 + F.tid] = n; n = wC[c] * n + f1[c] * DN[(size_t)(bh * 64 + c) * 128 + F.tid]; }
            a.out[O_NP + bh * 128 + F.tid] = n; }
    }
}

__device__ __forceinline__ void ml_out_unit(const Args& a, Frame& F, int unit) {
    const int c = unit & 63, bh = unit >> 6, hd = bh & 3, b = bh >> 2, row0 = b * SEQ + c * 128;
    const bf16* XM = (const bf16*)(a.ws + WS_XM); const bf16* KM = (const bf16*)(a.ws + WS_KM); const bf16* QM = (const bf16*)(a.ws + WS_QM);
    LAS float* as = (LAS float*)(F.lds + ML_ARR); LAS float* Ms = as + 128; LAS float* bs = as + 256; LAS float* ns = as + 384; LAS float* stt = as + 512;
    __syncthreads();
    ml_gates(a, F, row0, hd, as, bs, Ms, stt);
    const float mprev = ((const float*)(a.ws + WS_MPREV))[unit];
    if (F.tid < 128) Ms[F.tid] = fmaxf(Ms[F.tid], mprev);
    if (F.tid < 128) ns[F.tid] = ((const float*)(a.ws + WS_NPREV))[(size_t)unit * 128 + F.tid];
    for (int i = F.tid; i < 128 * 32; i += NTHREADS) { const int s = i >> 5, ch = i & 31;
        *(LAS v4u*)(F.lds + ML_VP + (ch >> 2) * ML_PLANE + s * 64 + (ch & 3) * 16) = *(const v4u*)(XM + (size_t)(row0 + s) * 1024 + hd * 256 + 8 * ch); }
    for (int i = F.tid; i < 128 * 16; i += NTHREADS) { const int s = i >> 4, ch = i & 15;
        *(LAS v4u*)(F.lds + ML_KP + s * ML_KROW + ch * 16) = *(const v4u*)(KM + (size_t)(row0 + s) * 512 + hd * 128 + 8 * ch); }
    __syncthreads();
    int l = F.lane; asm volatile("" : "+v"(l));
    const int w = F.wave, tw = w & 3, vh = w >> 2, i = l & 31, hh = l >> 5, i16 = l & 15, qq = i16 >> 2, pp = i16 & 3, g1 = (l >> 4) & 1;
    const int t = 32 * tw + i;
    bf16x8 qf[8];
#pragma unroll
    for (int ks = 0; ks < 8; ++ks) qf[ks] = *(const bf16x8*)(QM + (size_t)(row0 + t) * 512 + hd * 128 + 16 * ks + 8 * hh);
    f32x16 acc[4];
#pragma unroll
    for (int vt = 0; vt < 4; ++vt) acc[vt] = (f32x16){0.f, 0.f, 0.f, 0.f, 0.f, 0.f, 0.f, 0.f, 0.f, 0.f, 0.f, 0.f, 0.f, 0.f, 0.f, 0.f};
    const bf16* cp = (const bf16*)(a.ws + WS_CPREV) + ((size_t)unit * 256 + 128 * vh + i) * 128 + 8 * hh;
#pragma unroll
    for (int vt = 0; vt < 4; ++vt) {
#pragma unroll
        for (int ks = 0; ks < 8; ++ks) { const bf16x8 cf = *(const bf16x8*)(cp + (size_t)vt * 32 * 128 + 16 * ks); acc[vt] = __builtin_amdgcn_mfma_f32_32x32x16_bf16(cf, qf[ks], acc[vt], 0, 0, 0); }
        __builtin_amdgcn_sched_barrier(0);
    }
    float nq = 0.f;
#pragma unroll
    for (int ks = 0; ks < 8; ++ks)
#pragma unroll
        for (int j = 0; j < 8; ++j) nq += ns[16 * ks + 8 * hh + j] * bf1((bf16)qf[ks][j]);
    nq += __shfl_xor(nq, 32);
    const float Mt = Ms[t], winter = __expf(mprev - Mt);
#pragma unroll
    for (int vt = 0; vt < 4; ++vt)
#pragma unroll
        for (int rg = 0; rg < 16; ++rg) acc[vt][rg] *= winter;
    float den = 0.f;
    const LAS unsigned char* kb = F.lds + ML_KP + i * ML_KROW + 8 * hh * 2;
    const LAS unsigned char* vb = F.lds + ML_VP + (4 * vh) * ML_PLANE + (4 * hh + qq) * 64 + (16 * g1 + 4 * pp) * 2;
    const LAS float* asl = as + 4 * hh;
    for (int st = 0; st <= tw; ++st) {
        f32x16 X = {0.f, 0.f, 0.f, 0.f, 0.f, 0.f, 0.f, 0.f, 0.f, 0.f, 0.f, 0.f, 0.f, 0.f, 0.f, 0.f};
#pragma unroll
        for (int ks = 0; ks < 8; ++ks) { const bf16x8 kf = *(const LAS bf16x8*)(kb + st * 32 * ML_KROW + ks * 32); X = __builtin_amdgcn_mfma_f32_32x32x16_bf16(kf, qf[ks], X, 0, 0, 0); }
        const bool diag = st == tw;
#pragma unroll
        for (int rg = 0; rg < 16; ++rg) { const int so = (rg & 3) + 8 * (rg >> 2);
            float wgt = __expf(asl[st * 32 + so] - Mt);
            if (diag && so + 4 * hh > i) wgt = 0.f;
            const float p = X[rg] * wgt; X[rg] = p; den += p; }
#pragma unroll
        for (int s2 = 0; s2 < 2; ++s2) {
            v4u pw; pw.x = pg8::cvt_pk_bf16(X[8 * s2 + 0], X[8 * s2 + 1]); pw.y = pg8::cvt_pk_bf16(X[8 * s2 + 2], X[8 * s2 + 3]); pw.z = pg8::cvt_pk_bf16(X[8 * s2 + 4], X[8 * s2 + 5]); pw.w = pg8::cvt_pk_bf16(X[8 * s2 + 6], X[8 * s2 + 7]);
            const bf16x8 pf = __builtin_bit_cast(bf16x8, pw);
#pragma unroll
            for (int vt = 0; vt < 4; ++vt) {
                const s16x4 lo = tr_read(vb + vt * ML_PLANE + (st * 32 + 16 * s2) * 64), hi = tr_read(vb + vt * ML_PLANE + (st * 32 + 16 * s2) * 64 + 512);
                const bf16x8 vf = (bf16x8){lo[0], lo[1], lo[2], lo[3], hi[0], hi[1], hi[2], hi[3]};
                acc[vt] = __builtin_amdgcn_mfma_f32_32x32x16_bf16(vf, pf, acc[vt], 0, 0, 0);
            }
        }
    }
    den += __shfl_xor(den, 32);
    den += winter * nq;
    const float rden = 1.f / fmaxf(fabsf(den), __expf(-bs[t] - Mt));
    float s1 = 0.f;
#pragma unroll
    for (int vt = 0; vt < 4; ++vt)
#pragma unroll
        for (int rg = 0; rg < 16; ++rg) { acc[vt][rg] *= rden; s1 += acc[vt][rg]; }
    s1 += __shfl_xor(s1, 32);
    if (hh == 0) stt[w * 32 + i] = s1;
    __syncthreads();
    const float mu = (stt[w * 32 + i] + stt[(w ^ 4) * 32 + i]) * (1.f / 256.f);
    float s2v = 0.f;
#pragma unroll
    for (int vt = 0; vt < 4; ++vt)
#pragma unroll
        for (int rg = 0; rg < 16; ++rg) { acc[vt][rg] -= mu; s2v += acc[vt][rg] * acc[vt][rg]; }
    s2v += __shfl_xor(s2v, 32);
    __syncthreads();
    if (hh == 0) stt[w * 32 + i] = s2v;
    __syncthreads();
    const float rs = rsqrtf((stt[w * 32 + i] + stt[(w ^ 4) * 32 + i]) * (1.f / 256.f) + EPS);
    LAS unsigned char* hrow = F.lds + t * ML_HROW + (128 * vh + 4 * hh) * 2;
#pragma unroll
    for (int vt = 0; vt < 4; ++vt)
#pragma unroll
        for (int rg = 0; rg < 4; ++rg) { v2u o; o.x = pg8::cvt_pk_bf16(acc[vt][4 * rg] * rs, acc[vt][4 * rg + 1] * rs); o.y = pg8::cvt_pk_bf16(acc[vt][4 * rg + 2] * rs, acc[vt][4 * rg + 3] * rs);
            *(LAS v2u*)(hrow + (32 * vt + 8 * rg) * 2) = o; }
    __syncthreads();
    const bf16* OM = (const bf16*)(a.ws + WS_OM); const bf16* ZM = (const bf16*)(a.ws + WS_ZM); const bf16* CA = (const bf16*)(a.ws + WS_CACT); bf16* A4 = (bf16*)(a.ws + WS_A4);
    for (int idx = F.tid; idx < 128 * 32; idx += NTHREADS) { const int tt = idx >> 5, ch = idx & 31; const size_t off = (size_t)(row0 + tt) * 1024 + hd * 256 + 8 * ch;
        const v4u hn = *(const LAS v4u*)(F.lds + tt * ML_HROW + ch * 16), om = *(const v4u*)(OM + off), zm = *(const v4u*)(ZM + off), ca = *(const v4u*)(CA + off);
        const f32x4 n0 = *(const f32x4*)(a.in[I_MNORM] + hd * 256 + 8 * ch), n1 = *(const f32x4*)(a.in[I_MNORM] + hd * 256 + 8 * ch + 4), k0 = *(const f32x4*)(a.in[I_MSKIP] + hd * 256 + 8 * ch), k1 = *(const f32x4*)(a.in[I_MSKIP] + hd * 256 + 8 * ch + 4);
        v4u o;
        o.x = pk2((bflo(om.x) * bflo(hn.x) * n0.x + k0.x * bflo(ca.x)) * bflo(zm.x), (bfhi(om.x) * bfhi(hn.x) * n0.y + k0.y * bfhi(ca.x)) * bfhi(zm.x));
        o.y = pk2((bflo(om.y) * bflo(hn.y) * n0.z + k0.z * bflo(ca.y)) * bflo(zm.y), (bfhi(om.y) * bfhi(hn.y) * n0.w + k0.w * bfhi(ca.y)) * bfhi(zm.y));
        o.z = pk2((bflo(om.z) * bflo(hn.z) * n1.x + k1.x * bflo(ca.z)) * bflo(zm.z), (bfhi(om.z) * bfhi(hn.z) * n1.y + k1.y * bfhi(ca.z)) * bfhi(zm.z));
        o.w = pk2((bflo(om.w) * bflo(hn.w) * n1.z + k1.z * bflo(ca.w)) * bflo(zm.w), (bfhi(om.w) * bfhi(hn.w) * n1.w + k1.w * bfhi(ca.w)) * bfhi(zm.w));
        *(v4u*)(A4 + off) = o; }
}

struct SampleOrder {
    int c;
    __device__ __forceinline__ bool next(int i, pg8::Unit& u) const { if (i > 0 || c < 0 || c >= 4) return false; u.pm = 64; u.pn = c; return true; }
    __device__ __forceinline__ void a_ready(const pg8::Unit&) const {}
    __device__ __forceinline__ void done(const pg8::Unit&) const {}
};

struct EpiMQK {
    static constexpr bool PERM = true, AFTER_DRAIN = false;
    unsigned char* ws;
    __device__ __forceinline__ void operator()(const pg8::f32x4 (&acc)[2][2][4][2], const pg8::Unit& u, int wr, int wc, int fr, int fq) const {
        const int row0 = u.pm * 256 + wr * 64 + fr, col = u.pn * 128 + wc * 32 + 8 * fq;
#pragma unroll
        for (int ai = 0; ai < 2; ++ai)
#pragma unroll
            for (int m = 0; m < 4; ++m)
#pragma unroll
                for (int bj = 0; bj < 2; ++bj) { bf16* dst = (bf16*)(ws + (bj ? WS_KM : WS_QM)) + (size_t)(row0 + ai * 128 + m * 16) * 512 + col;
                    const pg8::f32x4 v0 = acc[ai][bj][m][0], v1 = acc[ai][bj][m][1];
                    v4u w; w.x = pg8::cvt_pk_bf16(v0[0], v0[1]); w.y = pg8::cvt_pk_bf16(v0[2], v0[3]); w.z = pg8::cvt_pk_bf16(v1[0], v1[1]); w.w = pg8::cvt_pk_bf16(v1[2], v1[3]);
                    *(v4u*)dst = w; }
    }
};
template <int STAGE> struct EpiBranch {
    static constexpr bool PERM = true, AFTER_DRAIN = false;
    unsigned char* ws;
    __device__ __forceinline__ void operator()(const pg8::f32x4 (&acc)[2][2][4][2], const pg8::Unit& u, int wr, int wc, int fr, int fq) const {
        const int row0 = u.pm * 256 + wr * 64 + fr, col0 = u.pn * 256 + wc * 32 + 8 * fq;
        const bf16* G = (const bf16*)(ws + (STAGE == 0 ? WS_GA : WS_GM)); bf16* PA = (bf16*)(ws + WS_PA); bf16* MR = (bf16*)(ws + WS_MRG);
#pragma unroll
        for (int ai = 0; ai < 2; ++ai)
#pragma unroll
            for (int m = 0; m < 4; ++m)
#pragma unroll
                for (int bj = 0; bj < 2; ++bj) { const size_t off = (size_t)(row0 + ai * 128 + m * 16) * 1024 + col0 + bj * 128;
                    const v4u gg = *(const v4u*)(G + off); const pg8::f32x4 v0 = acc[ai][bj][m][0], v1 = acc[ai][bj][m][1];
                    float r[8] = {v0[0] * bflo(gg.x), v0[1] * bfhi(gg.x), v0[2] * bflo(gg.y), v0[3] * bfhi(gg.y), v1[0] * bflo(gg.z), v1[1] * bfhi(gg.z), v1[2] * bflo(gg.w), v1[3] * bfhi(gg.w)};
                    if (STAGE == 1) { const v4u pp = *(const v4u*)(PA + off); r[0] += bflo(pp.x); r[1] += bfhi(pp.x); r[2] += bflo(pp.y); r[3] += bfhi(pp.y); r[4] += bflo(pp.z); r[5] += bfhi(pp.z); r[6] += bflo(pp.w); r[7] += bfhi(pp.w); }
                    v4u w; w.x = pg8::cvt_pk_bf16(r[0], r[1]); w.y = pg8::cvt_pk_bf16(r[2], r[3]); w.z = pg8::cvt_pk_bf16(r[4], r[5]); w.w = pg8::cvt_pk_bf16(r[6], r[7]);
                    *(v4u*)((STAGE == 0 ? PA : MR) + off) = w; }
    }
};
struct EpiOut {
    static constexpr bool PERM = false, AFTER_DRAIN = false;
    unsigned char* ws; float* out; const float* xp; const float* xs;
    __device__ __forceinline__ void operator()(const pg8::f32x4 (&acc)[2][2][4][2], const pg8::Unit& u, int wr, int wc, int fr, int fq) const {
        const int row0 = u.pm * 256 + wr * 64 + fr, col0 = u.pn * 256 + wc * 32 + 4 * fq;
        const float* gate = (const float*)(ws + WS_GATE); float* SSQ = (float*)(ws + WS_SSQ);
#pragma unroll
        for (int ai = 0; ai < 2; ++ai)
#pragma unroll
            for (int m = 0; m < 4; ++m) { const int r = row0 + ai * 128 + m * 16;
                const int b = r < MP ? (r >> 13) : 2 + ((r - MP) >> 3);
                const float* xrow = r < MP ? xp + (size_t)r * 1024 : xs + (size_t)(r - MP) * 1024;
                float ss = 0.f;
#pragma unroll
                for (int bj = 0; bj < 2; ++bj)
#pragma unroll
                    for (int n = 0; n < 2; ++n) { const int c = col0 + bj * 128 + n * 16;
                        const pg8::f32x4 gv = *(const pg8::f32x4*)(gate + (size_t)b * 1024 + c), xv = *(const pg8::f32x4*)(xrow + c);
                        const pg8::f32x4 y = xv + gv * acc[ai][bj][m][n];
                        ss += (y[0] * y[0] + y[1] * y[1]) + (y[2] * y[2] + y[3] * y[3]);
                        *(pg8::f32x4*)(out + (size_t)r * 1024 + c) = y; }
                ss += __shfl_xor(ss, 16); ss += __shfl_xor(ss, 32);
                if (fq == 0) SSQ[(size_t)r * 16 + u.pn * 4 + wc] = ss; }
    }
};
__device__ __forceinline__ void final_norm(const Args& a, Frame& F) {
    const int gw = F.vcu * NWAVES + F.wave, NGW = F.G * NWAVES; const float* SSQ = (const float*)(a.ws + WS_SSQ); const float* fg = a.in[I_FG];
    for (int r = gw; r < M; r += NGW) {
        float s = F.lane < 16 ? SSQ[(size_t)r * 16 + F.lane] : 0.f; s = wave_sum(s);
        const float rstd = rsqrtf(s * (1.f / 1024.f) + EPS);
        f32x4* row = (f32x4*)(a.out + (size_t)r * 1024);
#pragma unroll
        for (int j = 0; j < 4; ++j) { const f32x4 y = row[64 * j + F.lane], g = *(const f32x4*)(fg + 4 * (64 * j + F.lane)); row[64 * j + F.lane] = y * rstd * g; }
    }
}

#ifndef MK_SPLIT
#define MK_SPLIT 0
#endif
constexpr int N_PHASES = 11;
__global__ void __launch_bounds__(NTHREADS, 2) mk_fwd(Args args) {
    extern __shared__ __attribute__((aligned(16))) unsigned char lds_raw[];
    Frame F;
    F.lds = (LAS unsigned char*)lds_raw;
    F.MISC = (volatile LAS unsigned*)(F.lds + MISC_OFF);
    F.tid = threadIdx.x; F.lane = F.tid & 63; F.wave = __builtin_amdgcn_readfirstlane(F.tid >> 6);
    F.G = gridDim.x; { const int bx = blockIdx.x; F.vcu = (F.G % 8 == 0) ? (bx % 8) * (F.G / 8) + bx / 8 : bx; }
    F.ctl = (gu32*)(args.ws + WS_CTL);
    for (int u = F.tid; u < (LDS_BYTES - LDSCTL_OFF) / 4; u += NTHREADS) ((LAS unsigned*)(F.lds + LDSCTL_OFF))[u] = 0u;
    __syncthreads();
    XcdBarrier bar; bar.bar = (unsigned*)(F.ctl + CW_BAR); bar.x = 0; bar.st = nullptr;
    if (!MK_SPLIT) bar = xcd_barrier_post((unsigned*)(F.ctl + CW_BAR), F.MISC + 8);
    const int lo = args.ph_lo, hi = args.ph_hi;
#ifndef PH_DUP
#define PH_DUP 0
#endif
#ifndef P3_REP
#define P3_REP 0
#endif
#ifndef PH_MASK
#define PH_MASK 0xffff
#endif
#define IN(k) (((PH_MASK >> (k)) & 1) && lo <= (k) && (k) < hi)
#define SEAM(k) do { if (IN(k) && IN((k) + 1)) xcd_barrier(bar); } while (0)

#define PBODY0 do { p0_prologue(args, F); } while (0)
    if (IN(0)) { PBODY0; if ((PH_DUP >> 0) & 1) { xcd_barrier(bar); PBODY0; } } SEAM(0);
#define PBODY1 do { p1_hprep(args, F); } while (0)
    if (IN(1)) { PBODY1; if ((PH_DUP >> 1) & 1) { xcd_barrier(bar); PBODY1; } } SEAM(1);
#define PBODY2 do { pg8::Gemm g{(const pg8::bf16_t*)(args.ws + WS_HN), (const pg8::bf16_t*)(args.ws + WS_WIN), M, NREG, 1024, 1024, 0}; \
        pg8::StaticOrder S; S.init(M, NREG, F.G, (int)blockIdx.x); \
        EpiG1 E{args.ws, args.out}; \
        pg8::gemm_phase<EpiG1, pg8::StaticOrder, true, true>(F.lds, g, S, E); } while (0)
    if (IN(2)) { PBODY2; if ((PH_DUP >> 2) & 1) { xcd_barrier(bar); PBODY2; } } SEAM(2);
#define PBODY3 do { for (int rep_ = 0; rep_ < (P3_REP == 1 ? 2 : 1); ++rep_) for (int task = F.vcu * NWAVES + F.wave; task < M / 4; task += F.G * NWAVES) conv_task(args, F, task); \
        LAS float* pscr = (LAS float*)(F.lds + F.wave * 1024); \
        const int gw = F.vcu * NWAVES + F.wave, NGW = F.G * NWAVES; \
        for (int rep_ = 0; rep_ < (P3_REP == 2 ? 2 : 1); ++rep_) for (int task = gw; task < MS * 24; task += NGW) { const int row = MP + task / 24, gh = task % 24; attn_valu_task(args, F, row, gh >> 3, gh & 7, pscr); }     \
        __syncthreads(); } while (0)
    if (IN(3)) { PBODY3; if ((PH_DUP >> 3) & 1) { xcd_barrier(bar); PBODY3; } } SEAM(3);
#define PBODY4 do { pg8::Gemm g{(const pg8::bf16_t*)(args.ws + WS_CACT), (const pg8::bf16_t*)(args.ws + WS_WQK), M, 1024, 256, 1024, 256}; \
        pg8::StaticOrder S; S.init(M, 1024, F.G, (int)blockIdx.x); \
        EpiMQK E{args.ws}; \
        pg8::gemm_phase<EpiMQK, pg8::StaticOrder, true, true>(F.lds, g, S, E); \
        combine_rows(args, F, MP, M); } while (0)
    if (IN(4)) { PBODY4; if ((PH_DUP >> 4) & 1) { xcd_barrier(bar); PBODY4; } } SEAM(4);
#define PBODY5 do { for (int it = F.vcu; it < NUNIT + DBS * 4; it += F.G) { \
            if (it < NUNIT) ml_dc_unit(args, F, it); \
            else { const int u = it - NUNIT, b = u >> 2, hd = u & 3; \
                mlstm_recurrent_unit(args, F, MP + b * 8, 8, hd, args.in[I_SC] + (size_t)u * 32768, args.in[I_SN] + (size_t)u * 128, args.in[I_SM] + u, \
                                     args.out + O_CSTS + (size_t)u * 32768, args.out + O_NS + (size_t)u * 128, args.out + O_MS + u); } \
        } \
        if (F.vcu >= 128) { __syncthreads(); attn_prompt_phase(args, F, F.vcu - 128, F.G - 128, ATT_P5); } } while (0)
    if (IN(5)) { PBODY5; if ((PH_DUP >> 5) & 1) { xcd_barrier(bar); PBODY5; } } SEAM(5);
#define PBODY6 do { ml_cscan(args, F); \
        if (F.vcu < F.G - 4) { __syncthreads(); attn_prompt_phase(args, F, ATT_P5 + F.vcu, F.G - 4, NAU); } \
        if (F.vcu >= F.G - 4) {                                        \
            __syncthreads(); \
            SampleOrder S{F.vcu - (F.G - 4)}; \
            { pg8::Gemm g{(const pg8::bf16_t*)(args.ws + WS_A3), (const pg8::bf16_t*)(args.ws + WS_WPA), M, 1024, 512, 512, 0}; EpiBranch<0> E{args.ws}; \
              pg8::gemm_phase<EpiBranch<0>, SampleOrder, false, true>(F.lds, g, S, E); } \
            VM_WAIT(); __syncthreads(); \
            { pg8::Gemm g{(const pg8::bf16_t*)(args.ws + WS_A4), (const pg8::bf16_t*)(args.ws + WS_WPM), M, 1024, 1024, 1024, 0}; EpiBranch<1> E{args.ws}; \
              pg8::gemm_phase<EpiBranch<1>, SampleOrder, false, true>(F.lds, g, S, E); } \
        } } while (0)
    if (IN(6)) { PBODY6; if ((PH_DUP >> 6) & 1) { xcd_barrier(bar); PBODY6; } } SEAM(6);
#define PBODY7 do { for (int it = F.vcu; it < NUNIT; it += F.G) ml_out_unit(args, F, it); \
        __syncthreads(); \
        if (F.vcu >= F.G - 4) {                                        \
            SampleOrder S{F.vcu - (F.G - 4)}; \
            pg8::Gemm g{(const pg8::bf16_t*)(args.ws + WS_MRG), (const pg8::bf16_t*)(args.ws + WS_WOUT), M, 1024, 1024, 1024, 0}; EpiOut E{args.ws, args.out, args.in[I_XP], args.in[I_XS]}; \
            pg8::gemm_phase<EpiOut, SampleOrder, false, true>(F.lds, g, S, E); \
        } \
        combine_rows(args, F, 0, MP); } while (0)
    if (IN(7)) { PBODY7; if ((PH_DUP >> 7) & 1) { xcd_barrier(bar); PBODY7; } } SEAM(7);
#define PBODY8 do { { pg8::Gemm g{(const pg8::bf16_t*)(args.ws + WS_A3), (const pg8::bf16_t*)(args.ws + WS_WPA), MP, 1024, 512, 512, 0}; \
          pg8::StaticOrder S; S.init(MP, 1024, F.G, (int)blockIdx.x); EpiBranch<0> E{args.ws}; \
          pg8::gemm_phase<EpiBranch<0>, pg8::StaticOrder, true, true>(F.lds, g, S, E); } \
        VM_WAIT(); __syncthreads(); \
        { pg8::Gemm g{(const pg8::bf16_t*)(args.ws + WS_A4), (const pg8::bf16_t*)(args.ws + WS_WPM), MP, 1024, 1024, 1024, 0}; \
          pg8::StaticOrder S; S.init(MP, 1024, F.G, (int)blockIdx.x); EpiBranch<1> E{args.ws}; \
          pg8::gemm_phase<EpiBranch<1>, pg8::StaticOrder, true, true>(F.lds, g, S, E); } } while (0)
    if (IN(8)) { PBODY8; if ((PH_DUP >> 8) & 1) { xcd_barrier(bar); PBODY8; } } SEAM(8);
#define PBODY9 do { pg8::Gemm g{(const pg8::bf16_t*)(args.ws + WS_MRG), (const pg8::bf16_t*)(args.ws + WS_WOUT), MP, 1024, 1024, 1024, 0}; \
        pg8::StaticOrder S; S.init(MP, 1024, F.G, (int)blockIdx.x); EpiOut E{args.ws, args.out, args.in[I_XP], args.in[I_XS]}; \
        pg8::gemm_phase<EpiOut, pg8::StaticOrder, true, true>(F.lds, g, S, E); } while (0)
    if (IN(9)) { PBODY9; if ((PH_DUP >> 9) & 1) { xcd_barrier(bar); PBODY9; } } SEAM(9);
#define PBODY10 do { final_norm(args, F); } while (0)
    if (IN(10)) { PBODY10; }
#undef IN
#undef SEAM
}

extern "C" void kernel_launch(void* const* d_in, const int* in_sizes, int n_in, void* d_out, int out_size, void* d_ws, size_t ws_size, hipStream_t stream) {
    static int grid = 0;
    if (grid == 0) {
        if (n_in != N_IN || (size_t)out_size != O_END || ws_size < WS_END) { fprintf(stderr, "kernel_launch: unexpected shapes: n_in %d out %d ws %zu (need %zu)\n", n_in, out_size, ws_size, (size_t)WS_END); grid = -1; return; }
        int dev = 0, cus = 0, per_cu = 0;
        if (hipGetDevice(&dev) != hipSuccess || hipDeviceGetAttribute(&cus, hipDeviceAttributeMultiprocessorCount, dev) != hipSuccess) { grid = -1; return; }
        if (hipFuncSetAttribute((const void*)mk_fwd, hipFuncAttributeMaxDynamicSharedMemorySize, LDS_BYTES) != hipSuccess) { fprintf(stderr, "kernel_launch: hipFuncSetAttribute failed\n"); grid = -1; return; }
        if (hipOccupancyMaxActiveBlocksPerMultiprocessor(&per_cu, (const void*)mk_fwd, NTHREADS, LDS_BYTES) != hipSuccess || per_cu < 1) { fprintf(stderr, "kernel_launch: occupancy query says %d blocks per CU\n", per_cu); (void)hipGetLastError(); grid = -1; return; }
        grid = cus;
    }
    if (grid < 0) return;
    if (hipMemsetAsync((char*)d_ws + WS_CTL, 0, CTL_ZERO_BYTES, stream) != hipSuccess) return;
    Args a{};
    for (int i = 0; i < N_IN; ++i) a.in[i] = (const float*)d_in[i];
    a.out = (float*)d_out; a.ws = (unsigned char*)d_ws;
#if MK_SPLIT
    for (int p = 0; p < N_PHASES; ++p) { a.ph_lo = p; a.ph_hi = p + 1; hipLaunchKernelGGL(mk_fwd, dim3(grid), dim3(NTHREADS), LDS_BYTES, stream, a); }
#else
    a.ph_lo = 0; a.ph_hi = N_PHASES;
    void* kargs[] = {&a};
    hipError_t e = hipLaunchCooperativeKernel((const void*)mk_fwd, dim3(grid), dim3(NTHREADS), kargs, LDS_BYTES, stream);
    if (e != hipSuccess) fprintf(stderr, "kernel_launch: cooperative launch failed: %s (grid %d)\n", hipGetErrorString(e), grid);
#endif
}
```
